# Optimizing an MI355X kernel written in HIP

```python
import math
import jax, jax.numpy as jnp
from jax import lax
import numpy as np

D_MODEL = 1024
BATCH = 16
SEQ = 2048
DEPTH = 1

SSM_WIDTH = D_MODEL // 2
SSM_GROUP = 16
SSM_GROUPS = SSM_WIDTH // SSM_GROUP
SSM_STATE = 64
N_DIR = 2
DT_MIN = 1e-3
DT_MAX = 1e-1
FFT_WIDTH = D_MODEL // 2
FFT_GROUPS = 4
FFT_GROUP = FFT_WIDTH // FFT_GROUPS
D_FF = 4 * D_MODEL
D_PLE = 256
EPS = 1e-6
IN_WIDTH = SSM_WIDTH + FFT_WIDTH + 2 * D_MODEL

kernel_name = 'hybrid_s5_fnet_gated_encoder_block'


def rms_norm(x, g):
    x32 = x.astype(jnp.float32)
    y = x32 * lax.rsqrt(jnp.mean(x32 * x32, axis=-1, keepdims=True) + EPS)
    return (y * g.astype(jnp.float32)).astype(x.dtype)


def _ssm_combine(left, right):
    a1, b1 = left
    a2, b2 = right
    return (a1 * a2, a2 * b1 + b2)


def s5_scan(u32, lam_re, lam_im, log_dt, b_re, b_im, c_re, c_im, reverse):
    f32 = jnp.float32
    lam = lax.complex(lam_re.astype(f32), lam_im.astype(f32))
    dt = jnp.exp(log_dt.astype(f32))[:, None]
    a_bar = jnp.exp(lam * dt)
    b = lax.complex(b_re.astype(f32), b_im.astype(f32))
    b_bar = ((a_bar - 1.0) / lam)[:, :, None] * b
    bu = jnp.einsum('bsgh,gph->bsgp', u32.astype(jnp.complex64), b_bar)
    a_seq = jnp.broadcast_to(a_bar, (1, u32.shape[1]) + a_bar.shape)
    _, states = lax.associative_scan(_ssm_combine, (a_seq, bu), reverse=reverse, axis=1)
    c = lax.complex(c_re.astype(f32), c_im.astype(f32))
    return jnp.real(jnp.einsum('bsgp,ghp->bsgh', states, c))


def s5_branch(u, lam_re, lam_im, log_dt, b_re, b_im, c_re, c_im, d_skip, w_glu):
    bsz, seq = u.shape[0], u.shape[1]
    f32 = jnp.float32
    u32 = u.astype(f32)
    ug = u32.reshape(bsz, seq, SSM_GROUPS, SSM_GROUP)
    y = (s5_scan(ug, lam_re[0], lam_im[0], log_dt[0], b_re[0], b_im[0], c_re[0], c_im[0], False)
         + s5_scan(ug, lam_re[1], lam_im[1], log_dt[1], b_re[1], b_im[1], c_re[1], c_im[1], True))
    y = y.reshape(bsz, seq, SSM_WIDTH) + d_skip.astype(f32) * u32
    a = jax.nn.gelu(y)
    val, gate = jnp.split(a @ w_glu.astype(f32), 2, axis=-1)
    return (val * jax.nn.sigmoid(gate)).astype(u.dtype)


def fnet_branch(u, w_fnet):
    bsz, seq = u.shape[0], u.shape[1]
    ug = u.astype(jnp.float32).reshape(bsz, seq, FFT_GROUPS, FFT_GROUP)
    mixed = jnp.fft.fft2(ug, axes=(1, 3), norm='ortho').real
    mixed = mixed.reshape(bsz, seq, FFT_WIDTH).astype(u.dtype)
    return mixed @ w_fnet


def setup_inputs(seed: int = 0) -> dict:
    key = jax.random.key(seed)
    ks = jax.random.split(key, 24)
    f32 = jnp.float32
    L = DEPTH

    def nrm(k, shape, scale):
        return jax.random.normal(k, shape, f32) * scale

    n_idx = jnp.arange(SSM_STATE, dtype=f32)
    lam_shape = (L, N_DIR, SSM_GROUPS, SSM_STATE)
    b_shape = (L, N_DIR, SSM_GROUPS, SSM_STATE, SSM_GROUP)
    c_shape = (L, N_DIR, SSM_GROUPS, SSM_GROUP, SSM_STATE)
    return {
        'x': nrm(ks[0], (BATCH, SEQ, D_MODEL), 1.0),
        'p': nrm(ks[1], (DEPTH, BATCH, SEQ, D_PLE), 1.0),
        'g_mix': 1.0 + nrm(ks[2], (L, D_MODEL), 0.02),
        'w_in': nrm(ks[3], (L, D_MODEL, IN_WIDTH), D_MODEL ** -0.5),
        'lam_re': -0.5 + nrm(ks[4], lam_shape, 0.01),
        'lam_im': math.pi * n_idx + nrm(ks[5], lam_shape, 0.01),
        'log_dt': jax.random.uniform(ks[6], (L, N_DIR, SSM_GROUPS), f32, math.log(DT_MIN), math.log(DT_MAX)),
        'b_re': nrm(ks[7], b_shape, (2 * SSM_GROUP) ** -0.5),
        'b_im': nrm(ks[8], b_shape, (2 * SSM_GROUP) ** -0.5),
        'c_re': nrm(ks[9], c_shape, SSM_STATE ** -0.5),
        'c_im': nrm(ks[10], c_shape, SSM_STATE ** -0.5),
        'd_skip': nrm(ks[11], (L, SSM_WIDTH), 1.0),
        'w_glu': nrm(ks[12], (L, SSM_WIDTH, 2 * D_MODEL), SSM_WIDTH ** -0.5),
        'w_fnet': nrm(ks[13], (L, FFT_WIDTH, D_MODEL), FFT_WIDTH ** -0.5),
        'w_out': nrm(ks[14], (L, D_MODEL, D_MODEL), D_MODEL ** -0.5),
        'g_ffn': 1.0 + nrm(ks[15], (L, D_MODEL), 0.02),
        'w_up': nrm(ks[16], (L, D_MODEL, D_FF), D_MODEL ** -0.5),
        'w_down': nrm(ks[17], (L, D_FF, D_MODEL), D_FF ** -0.5),
        'g_ple': 1.0 + nrm(ks[18], (L, D_MODEL), 0.02),
        'w_ple_gate': nrm(ks[19], (L, D_MODEL, D_MODEL), D_MODEL ** -0.5),
        'w_ple': nrm(ks[20], (L, D_PLE, D_MODEL), D_PLE ** -0.5),
        'g_final': 1.0 + nrm(ks[21], (D_MODEL,), 0.02),
    }


def reference(x, p, g_mix, w_in, lam_re, lam_im, log_dt, b_re, b_im, c_re, c_im, d_skip,
              w_glu, w_fnet, w_out, g_ffn, w_up, w_down, g_ple, w_ple_gate, w_ple, g_final):
    split_at = [SSM_WIDTH, SSM_WIDTH + FFT_WIDTH, SSM_WIDTH + FFT_WIDTH + D_MODEL]
    for i in range(DEPTH):
        h = rms_norm(x, g_mix[i])
        proj = h @ w_in[i]
        u_ssm, u_fft, z_a, z_b = jnp.split(proj, split_at, axis=-1)
        y_a = s5_branch(u_ssm, lam_re[i], lam_im[i], log_dt[i], b_re[i], b_im[i],
                        c_re[i], c_im[i], d_skip[i], w_glu[i])
        y_b = fnet_branch(u_fft, w_fnet[i])
        merged = jax.nn.sigmoid(z_a) * y_a + jax.nn.sigmoid(z_b) * y_b
        x = x + merged @ w_out[i]
        h = rms_norm(x, g_ffn[i])
        x = x + jnp.square(jax.nn.relu(h @ w_up[i])) @ w_down[i]
        h = rms_norm(x, g_ple[i])
        x = x + jax.nn.sigmoid(h @ w_ple_gate[i]) * (p[i] @ w_ple[i])
    return rms_norm(x, g_final)
```

```cpp
#include <hip/hip_runtime.h>
#include <hip/hip_cooperative_groups.h>
#include <cstdio>
#include <cstdint>
#include <type_traits>
namespace cg = cooperative_groups;

#ifndef FAST_MASK
#define FAST_MASK 0x3FFF
#endif
#ifndef N_LAUNCH_MODE
#define N_LAUNCH_MODE 0
#endif

#ifndef PROBE_DUP
#define PROBE_DUP 0
#endif
#ifndef DBG_STOP
#define DBG_STOP -1
#endif
#define LAS __attribute__((address_space(3)))
typedef unsigned short bf16_t;
typedef short bf16x8 __attribute__((ext_vector_type(8)));
typedef float f32x4 __attribute__((ext_vector_type(4)));
typedef float f32x2 __attribute__((ext_vector_type(2)));
typedef unsigned u32x2 __attribute__((ext_vector_type(2)));
typedef unsigned u32x4 __attribute__((ext_vector_type(4)));

constexpr int T = 32768, D = 1024, SEQ = 2048, NB = 16, DFF = 4096, DPLE = 256;
constexpr int NG = 32;
constexpr float EPS = 1e-6f;
constexpr int NWAVES = 8, NTHR = 512;

constexpr size_t MiB = 1u << 20;
constexpr size_t WS_CTL = 0, CTL_BYTES = 1 * MiB;
constexpr size_t CTL_SS3 = 256 * 1024;
constexpr size_t CTL_CNT = 512 * 1024;
constexpr size_t WS_WIN = 1 * MiB;
constexpr size_t WS_WPLE = 7 * MiB;
constexpr size_t WS_MB = 8 * MiB;
constexpr size_t WS_WS5 = 12 * MiB;
constexpr size_t WS_DM = 20 * MiB;
constexpr size_t WS_WC = 28 * MiB;
constexpr size_t WS_WSN = 29 * MiB;
constexpr size_t WS_WGLU = 30 * MiB;
constexpr size_t WS_WOUT = 32 * MiB;
constexpr size_t WS_WUP = 34 * MiB;
constexpr size_t WS_WDOWN = 42 * MiB;
constexpr size_t WS_WG = 50 * MiB;
constexpr size_t WS_AL = 52 * MiB;
constexpr size_t WS_U1024 = 52 * MiB + 65536;
constexpr size_t WS_INVR = 52 * MiB + 131072;
constexpr size_t WS_SSP1 = 53 * MiB;
constexpr size_t WS_SSP2 = 55 * MiB;
constexpr size_t WS_PP = 60 * MiB;
constexpr size_t WS_XB = 124 * MiB;
constexpr size_t WS_Z = 188 * MiB;
constexpr size_t WS_XN = WS_Z;
constexpr size_t WS_XS = WS_Z + 64 * MiB;
constexpr size_t WS_UT = WS_Z + 128 * MiB;
constexpr size_t WS_ZA = WS_Z + 160 * MiB;
constexpr size_t WS_ZB = WS_Z + 224 * MiB;
constexpr size_t WS_PB = WS_Z + 288 * MiB;
constexpr size_t WS_R = WS_Z + 288 * MiB;
constexpr size_t WS_YS = WS_Z + 128 * MiB;
constexpr size_t WS_MG = WS_Z + 64 * MiB;
constexpr size_t WS_HHI = WS_Z + 128 * MiB;
constexpr size_t WS_END = WS_Z + 320 * MiB;

constexpr int RING_BYTES = 131072;
constexpr int RS_OFF = 135168;
constexpr int MISC_OFF = 143616;
constexpr int LDS_BYTES = 147456;

typedef __bf16 bf16x2_t __attribute__((ext_vector_type(2)));
__device__ __forceinline__ unsigned cvt_pk_bf16(float lo, float hi) { const f32x2 v = {lo, hi}; const bf16x2_t r = __builtin_convertvector(v, bf16x2_t); return __builtin_bit_cast(unsigned, r); }
__device__ __forceinline__ u32x2 pack4(f32x4 v) { u32x2 w; w.x = cvt_pk_bf16(v[0], v[1]); w.y = cvt_pk_bf16(v[2], v[3]); return w; }
__device__ __forceinline__ f32x4 unpack4(u32x2 w) { f32x4 v; v[0] = __uint_as_float(w.x << 16); v[1] = __uint_as_float(w.x & 0xffff0000u); v[2] = __uint_as_float(w.y << 16); v[3] = __uint_as_float(w.y & 0xffff0000u); return v; }
__device__ __forceinline__ u32x4 pack8(f32x4 lo, f32x4 hi) { u32x4 w; w.x = cvt_pk_bf16(lo[0], lo[1]); w.y = cvt_pk_bf16(lo[2], lo[3]); w.z = cvt_pk_bf16(hi[0], hi[1]); w.w = cvt_pk_bf16(hi[2], hi[3]); return w; }
__device__ __forceinline__ f32x4 unpack_lo(u32x4 w) { u32x2 t; t.x = w.x; t.y = w.y; return unpack4(t); }
__device__ __forceinline__ f32x4 unpack_hi(u32x4 w) { u32x2 t; t.x = w.z; t.y = w.w; return unpack4(t); }
__device__ __forceinline__ unsigned q8x4(f32x4 s) {
    return (unsigned)(s[0] * 255.f + 0.5f) | ((unsigned)(s[1] * 255.f + 0.5f) << 8) | ((unsigned)(s[2] * 255.f + 0.5f) << 16) | ((unsigned)(s[3] * 255.f + 0.5f) << 24); }
__device__ __forceinline__ f32x4 dq8x4(unsigned w) { f32x4 r; r[0] = (float)(w & 255u); r[1] = (float)((w >> 8) & 255u); r[2] = (float)((w >> 16) & 255u); r[3] = (float)(w >> 24); return r * (1.0f / 255.f); }
__device__ __forceinline__ float sigmoidf_(float x) { return __builtin_amdgcn_rcpf(1.0f + __builtin_amdgcn_exp2f(-1.4426950409f * x)); }
__device__ __forceinline__ f32x4 sigmoid4(f32x4 v) { f32x4 r; r[0] = sigmoidf_(v[0]); r[1] = sigmoidf_(v[1]); r[2] = sigmoidf_(v[2]); r[3] = sigmoidf_(v[3]); return r; }
__device__ __forceinline__ float gelu_tanh(float x) { return x * sigmoidf_(1.5957691216f * (x + 0.044715f * x * x * x)); }
__device__ __forceinline__ float wave_sum(float v) {
#pragma unroll
    for (int o = 1; o < 64; o <<= 1) v += __shfl_xor(v, o);
    return v;
}
#define LDS_WAIT() asm volatile("s_waitcnt lgkmcnt(0)" ::: "memory")


#define XB_TMO      128
#define XB_XCNT(j)  (256  + 64 * (j))
#define XB_XSUB(j)  (1280 + 64 * (j))
#define XB_XGEN(j)  (2304 + 64 * (j))
#define XB_TOP      3328
#define XB_TOPGEN   3392
#define XCD_BAR_WORDS 3456
#define XB_SPIN_CAP (1u << 18)
constexpr int CW_BAR = 4096;
__device__ __forceinline__ unsigned xb_ld(unsigned* p)              { return __hip_atomic_load(p, __ATOMIC_RELAXED, __HIP_MEMORY_SCOPE_AGENT); }
__device__ __forceinline__ unsigned xb_add(unsigned* p, unsigned v) { return __hip_atomic_fetch_add(p, v, __ATOMIC_RELAXED, __HIP_MEMORY_SCOPE_AGENT); }
__device__ __forceinline__ unsigned xb_xcc_id() { return (unsigned)__builtin_amdgcn_s_getreg((3 << 11) | 20) & 0xFu; }
#define XB_SPIN(cond, bar) do { unsigned _sp = 0; while (cond) { __builtin_amdgcn_s_sleep(1); \
    if ((++_sp & 255u) == 0u) { if (xb_ld(&(bar)[XB_TMO])) break; if (_sp > XB_SPIN_CAP) { atomicAdd(&(bar)[XB_TMO], 1u); break; } } } } while (0)
struct XcdBarrier { unsigned* bar; unsigned x; volatile LAS unsigned* st; };
__device__ __forceinline__ XcdBarrier xcd_barrier_post(unsigned* bar, volatile LAS unsigned* st) {
    XcdBarrier b; b.bar = bar; b.x = xb_xcc_id(); b.st = st;
    if (threadIdx.x == 0) (void)xb_add(&bar[XB_XCNT(b.x)], 1u);
    return b;
}
__device__ __forceinline__ void xcd_barrier_complete(unsigned* bar, unsigned x, unsigned& nloc, unsigned& nx) {
    const unsigned G = gridDim.x * gridDim.y * gridDim.z;
    unsigned sum, cnt, mine, sp = 0u;
    for (;;) {
        sum = 0u; cnt = 0u; mine = 0u;
#pragma unroll
        for (unsigned j = 0; j < 16; ++j) { const unsigned c = xb_ld(&bar[XB_XCNT(j)]); sum += c; cnt += (c > 0u) ? 1u : 0u; mine = (j == x) ? c : mine; }
        if (sum == G) break;
        __builtin_amdgcn_s_sleep(1);
        if ((++sp & 255u) == 0u) { if (xb_ld(&bar[XB_TMO])) break; if (sp > XB_SPIN_CAP) { atomicAdd(&bar[XB_TMO], 1u); break; } }
    }
    nloc = mine > 0u ? mine : 1u; nx = cnt > 0u ? cnt : 1u;
}
__device__ __forceinline__ void xcd_barrier(const XcdBarrier& b) {
    asm volatile("s_waitcnt vmcnt(0)" ::: "memory");
    __syncthreads();
    if (threadIdx.x == 0) {
        unsigned* bar = b.bar;
        __builtin_amdgcn_s_waitcnt(0);
        unsigned nloc = b.st[0], nx = b.st[1];
        if (nloc == 0u) { xcd_barrier_complete(bar, b.x, nloc, nx); b.st[0] = nloc; b.st[1] = nx; }
        const unsigned old = xb_add(&bar[XB_XSUB(b.x)], 1u);
        const unsigned gen = old / nloc;
        if (old + 1u == (gen + 1u) * nloc) {
            __builtin_amdgcn_fence(__ATOMIC_RELEASE, "agent");
            asm volatile("s_waitcnt vmcnt(0)" ::: "memory");
            const unsigned og = xb_add(&bar[XB_TOP], 1u);
            const unsigned tg = og / nx;
            if (og + 1u == (tg + 1u) * nx) xb_add(&bar[XB_TOPGEN], 1u);
            else XB_SPIN(xb_ld(&bar[XB_TOPGEN]) == tg, bar);
            __builtin_amdgcn_fence(__ATOMIC_ACQUIRE, "agent");
            xb_add(&bar[XB_XGEN(b.x)], 1u);
            asm volatile("s_waitcnt vmcnt(0)" ::: "memory");
        } else {
            XB_SPIN(xb_ld(&bar[XB_XGEN(b.x)]) == gen, bar);
            __builtin_amdgcn_fence(__ATOMIC_ACQUIRE, "agent");
            asm volatile("s_waitcnt vmcnt(0)" ::: "memory");
        }
    }
    __syncthreads();
}

constexpr int CW_TEAMX = 12288, CW_TEAMC = 16384;
struct TeamBar { unsigned* cnt; unsigned target; bool same; };
__device__ __forceinline__ void team_barrier(TeamBar& tb) {
    asm volatile("s_waitcnt vmcnt(0)" ::: "memory");
    __syncthreads();
    tb.target += 4u;
    if (threadIdx.x == 0) {
        __builtin_amdgcn_s_waitcnt(0);
        if (!tb.same) { __builtin_amdgcn_fence(__ATOMIC_RELEASE, "agent"); asm volatile("s_waitcnt vmcnt(0)" ::: "memory"); }
        xb_add(tb.cnt, 1u);
        { unsigned sp = 0; while (xb_ld(tb.cnt) < tb.target) { __builtin_amdgcn_s_sleep(1); if (++sp > (1u << 22)) break; } }
        __builtin_amdgcn_fence(__ATOMIC_ACQUIRE, "agent");
        asm volatile("s_waitcnt vmcnt(0)" ::: "memory");
    }
    __syncthreads();
}

struct Unit { const bf16_t* A; const bf16_t* B; const bf16_t* A2; int r0, c0, slot, aux, sub; };
constexpr int NXCD = 8, WGM = 8;
__device__ __forceinline__ bool unit_order(int L, int nM, int nN, int& pm, int& pn) {
    const int nwg = nM * nN; if (L >= nwg) return false;
    int wgid = L; { const int q = nwg / NXCD, r = nwg % NXCD, xcd = wgid % NXCD, off = wgid / NXCD; wgid = (xcd < r ? xcd * (q + 1) : r * (q + 1) + (xcd - r) * q) + off; }
    const int nig = WGM * nN, gid = wgid / nig, fm = gid * WGM, gsz = (nM - fm) < WGM ? (nM - fm) : WGM;
    pm = fm + ((wgid % nig) % gsz); pn = (wgid % nig) / gsz; return true;
}
enum SegKind { SG_P1MAIN = 0, SG_P1SWAP, SG_P1PP, SG_E, SG_DFT, SG_Y, SG_FNET, SG_GLU, SG_OUT, SG_UP, SG_DOWN, SG_GATE, SG_P1ALL  , SG_P3ALL  , SG_N };
struct Ptrs {
    const float* x; float* out; unsigned char* ws;
};
template <int KIND> struct Seg {
    unsigned char* ws; int G, c, only;
    const void* ext = nullptr;
    static constexpr bool SPLITA = (KIND == SG_DOWN);
    __device__ __forceinline__ static constexpr int nM() { return (KIND == SG_P1SWAP) ? 2 : (KIND == SG_E || KIND == SG_Y) ? 256 : 128; }
    __device__ __forceinline__ static constexpr int nN() { return KIND == SG_P1MAIN ? 10 : KIND == SG_P1SWAP ? 128 : KIND == SG_P1PP ? 4 : (KIND == SG_E || KIND == SG_Y) ? 1 : KIND == SG_DFT ? 2 : KIND == SG_FNET ? 4 : KIND == SG_GLU ? 8 : KIND == SG_UP ? 16 : 4; }
    static constexpr bool CUSTOMB = (KIND == SG_P1SWAP);
    static constexpr bool CUSTOMA = (KIND == SG_GLU);
    __device__ __forceinline__ static constexpr int lda() { return (KIND == SG_P1PP) ? 256 : (KIND == SG_E || KIND == SG_Y || KIND == SG_FNET || KIND == SG_GLU || KIND == SG_P3ALL) ? 512 : KIND == SG_DOWN ? 2048 : 1024; }
    __device__ __forceinline__ static constexpr int ldb() { return (KIND == SG_P1PP || KIND == SG_E) ? 256 : (KIND == SG_Y || KIND == SG_FNET || KIND == SG_GLU || KIND == SG_P3ALL) ? 512 : KIND == SG_DOWN ? 4096 : 1024; }
    __device__ __forceinline__ static constexpr int K() { return (KIND == SG_P1PP || KIND == SG_E) ? 256 : (KIND == SG_Y || KIND == SG_FNET || KIND == SG_GLU || KIND == SG_P3ALL) ? 512 : KIND == SG_DOWN ? 4096 : 1024; }
    __device__ __forceinline__ static constexpr int total() { return KIND == SG_P1ALL ? 1280 + 256 : KIND == SG_P3ALL ? 256 + 512 : nM() * nN(); }
    __device__ __forceinline__ int count() const { const int n = total(); return (n - c + G - 1) / G; }
    __device__ __forceinline__ bool next(int i, Unit& u) const {
        if (only >= 0) { if (i != 0) return false; i = only; }
        u.slot = i; u.aux = 0; u.sub = 0;
        if constexpr (KIND == SG_P1ALL) {
            const int L = i * G + c; int pm, pn; if (L >= total()) return false;
            if (L < 1280) { unit_order(L, 128, 10, pm, pn); u.A = (const bf16_t*)(ws + WS_XN) + (size_t)pm * 256 * 1024; u.B = (const bf16_t*)(ws + WS_WIN) + (size_t)(pn < 2 ? pn : pn + 2) * 256 * 1024; u.r0 = pm * 256; u.c0 = pn * 256; }
            else { unit_order(L - 1280, 2, 128, pm, pn); u.sub = 1; u.A = (const bf16_t*)(ws + WS_WIN) + (size_t)(512 + pm * 256) * 1024; u.B = (const bf16_t*)(ws + WS_XN) + (size_t)pn * 256 * 1024; u.r0 = pm * 256; u.c0 = pn * 256; }
            return true;
        }
        if constexpr (KIND == SG_P3ALL) {
            const int L = i * G + c; int pm, pn; if (L >= total()) return false;
            if (L < 256) { unit_order(L, 256, 1, pm, pn); const int g = pm >> 3, rt = pm & 7; u.A = (const bf16_t*)(ws + WS_XS) + ((size_t)g * 2048 + rt * 256) * 512; u.B = (const bf16_t*)(ws + WS_WS5) + (size_t)g * 131072; u.r0 = rt * 256; u.c0 = 0; u.aux = g; }
            else { unit_order(L - 256, 128, 4, pm, pn); u.sub = 1; u.A = (const bf16_t*)(ws + WS_R) + (size_t)pm * 256 * 512; u.B = (const bf16_t*)(ws + ((pm & 7) < 4 ? WS_WC : WS_WSN)) + (size_t)pn * 256 * 512; u.r0 = pm * 256; u.c0 = pn * 256; }
            return true;
        }
        int pm, pn; if (!unit_order(i * G + c, nM(), nN(), pm, pn)) return false;
        if constexpr (KIND == SG_P1MAIN) { u.A = (const bf16_t*)(ws + WS_XN) + (size_t)pm * 256 * 1024; u.B = (const bf16_t*)(ws + WS_WIN) + (size_t)(pn < 2 ? pn : pn + 2) * 256 * 1024; u.r0 = pm * 256; u.c0 = pn * 256; }
        if constexpr (KIND == SG_P1SWAP) { u.A = (const bf16_t*)(ws + WS_WIN) + (size_t)(512 + pm * 256) * 1024; u.B = (const bf16_t*)(ws + WS_XN) + (size_t)(pn >> 3) * 2048 * 1024; u.r0 = pm * 256; u.c0 = (pn & 7) * 128; u.aux = pn >> 3; }
        if constexpr (KIND == SG_P1PP) { u.A = (const bf16_t*)(ws + WS_PB) + (size_t)pm * 256 * 256; u.B = (const bf16_t*)(ws + WS_WPLE) + (size_t)pn * 256 * 256; u.r0 = pm * 256; u.c0 = pn * 256; }
        if constexpr (KIND == SG_E) { const int g = pm >> 3, rt = pm & 7; u.A = (const bf16_t*)(ws + WS_XS) + ((size_t)g * 2048 + rt * 256) * 512; u.B = (const bf16_t*)(ws + WS_MB) + (size_t)g * 65536; u.r0 = rt * 256; u.c0 = 0; u.aux = g; }
        if constexpr (KIND == SG_DFT) { const int b = pm >> 3, rt = pm & 7; u.A = (const bf16_t*)(ws + WS_DM) + (size_t)rt * 256 * 1024;
            u.B = (const bf16_t*)(ws + WS_UT) + ((size_t)(rt < 4 ? 0 : 16) * 512 + (size_t)b * 512 + pn * 256) * 1024; u.r0 = pm * 256; u.c0 = pn * 256; u.aux = b; }
        if constexpr (KIND == SG_Y) { const int g = pm >> 3, rt = pm & 7; u.A = (const bf16_t*)(ws + WS_XS) + ((size_t)g * 2048 + rt * 256) * 512; u.B = (const bf16_t*)(ws + WS_WS5) + (size_t)g * 131072; u.r0 = rt * 256; u.c0 = 0; u.aux = g; }
        if constexpr (KIND == SG_FNET) { u.A = (const bf16_t*)(ws + WS_R) + (size_t)pm * 256 * 512; u.B = (const bf16_t*)(ws + ((pm & 7) < 4 ? WS_WC : WS_WSN)) + (size_t)pn * 256 * 512; u.r0 = pm * 256; u.c0 = pn * 256; }
        if constexpr (KIND == SG_GLU) { const int b = pm >> 3, jt = pm & 7;
            u.A = (const bf16_t*)(ws + WS_YS) + ((size_t)b * 2048 + jt * 128) * 512; u.A2 = (const bf16_t*)(ws + WS_YS) + ((size_t)b * 2048 + 2048 - jt * 128 - 127) * 512;
            u.B = (const bf16_t*)(ws + WS_WGLU) + (size_t)pn * 256 * 512; u.r0 = b * 2048; u.c0 = pn * 128; u.aux = jt; u.sub = (jt == 0); }
        if constexpr (KIND == SG_OUT) { u.A = (const bf16_t*)(ws + WS_MG) + (size_t)pm * 256 * 1024; u.B = (const bf16_t*)(ws + WS_WOUT) + (size_t)pn * 256 * 1024; u.r0 = pm * 256; u.c0 = pn * 256; }
        if constexpr (KIND == SG_UP) { u.A = (const bf16_t*)(ws + WS_XB) + (size_t)pm * 256 * 1024; u.B = (const bf16_t*)(ws + WS_WUP) + (size_t)pn * 256 * 1024; u.r0 = pm * 256; u.c0 = pn * 256; }
        if constexpr (KIND == SG_DOWN) { u.A = (const bf16_t*)ext + (size_t)pm * 256 * 2048; u.A2 = (const bf16_t*)(ws + WS_HHI) + (size_t)pm * 256 * 2048; u.B = (const bf16_t*)(ws + WS_WDOWN) + (size_t)pn * 256 * 4096; u.r0 = pm * 256; u.c0 = pn * 256; }
        if constexpr (KIND == SG_GATE) { u.A = (const bf16_t*)(ws + WS_XB) + (size_t)pm * 256 * 1024; u.B = (const bf16_t*)(ws + WS_WG) + (size_t)pn * 256 * 1024; u.r0 = pm * 256; u.c0 = pn * 256; }
        return true;
    }
};

struct NoPre {};
struct EpiBase {
    static constexpr bool AFTER_DRAIN = false, WHOLE_TILE = false;
    static constexpr int MB = 4;
    typedef NoPre Pre;
    __device__ __forceinline__ void load(const Unit&, int, int, NoPre&) {}
    __device__ __forceinline__ void row_begin() {}
    __device__ __forceinline__ void row_end(const Unit&, int, int, int) {}
    __device__ __forceinline__ void half_done(const Unit&, int) {}
};
struct EpiStore : EpiBase {
    bf16_t* O; int ldo;
    __device__ __forceinline__ void pair8(const Unit& u, int lrow, int colq, f32x4 a0, f32x4 a1, f32x4 b0, f32x4 b1, const Pre&) {
        bf16_t* p = O + (size_t)(u.r0 + lrow) * ldo + u.c0 + colq;
        *(u32x4*)p = pack8(a0, a1); *(u32x4*)(p + 32) = pack8(b0, b1);
    }
};
struct EpiP1Main : EpiBase {
    unsigned char* ws;
    __device__ __forceinline__ void pair8(const Unit& u, int lrow, int colq, f32x4 a0, f32x4 a1, f32x4 b0, f32x4 b1, const Pre&) {
        const int t = u.r0 + lrow;
        if (u.c0 < 512) {
            const int b = t >> 11, pos = t & 2047, c = pos >> 4, j = pos & 15;
#pragma unroll
            for (int bj = 0; bj < 2; ++bj) { const int vcol = u.c0 + colq + bj * 32, g = vcol >> 4, h = vcol & 15;
                bf16_t* p = (bf16_t*)(ws + WS_XS) + ((size_t)g * 2048 + b * 128 + c) * 512 + j * 16 + h; *(u32x4*)p = bj ? pack8(b0, b1) : pack8(a0, a1); }
        } else {
            const int zc = u.c0 - 512; unsigned char* base = ws + (zc < 1024 ? WS_ZA : WS_ZB) + (size_t)t * 1024 + (zc & 1023) + colq;
            u32x2 wa, wb; wa.x = q8x4(sigmoid4(a0)); wa.y = q8x4(sigmoid4(a1)); wb.x = q8x4(sigmoid4(b0)); wb.y = q8x4(sigmoid4(b1));
            *(u32x2*)base = wa; *(u32x2*)(base + 32) = wb;
        }
    }
};
struct EpiP1Swap : EpiBase {
    unsigned char* ws;
    __device__ __forceinline__ void pair8(const Unit& u, int lrow, int colq, f32x4 a0, f32x4 a1, f32x4 b0, f32x4 b1, const Pre&) {
        const int ch = u.r0 + lrow, n0 = u.c0 + (colq >> 6) * 32 + (colq & 63);
        f32x4 e0 = a0 + b0, e1 = a1 + b1, o0 = a0 - b0, o1 = a1 - b1;
        if (n0 == 0) { e0[0] = a0[0]; o0[0] = 0.f; ((float*)(ws + WS_U1024))[u.aux * 512 + ch] = b0[0]; }
        const size_t off = ((size_t)u.aux * 512 + ch) * 1024 + n0;
        *(u32x4*)((bf16_t*)(ws + WS_UT) + off) = pack8(e0, e1);
        *(u32x4*)((bf16_t*)(ws + WS_UT) + (size_t)16 * 512 * 1024 + off) = pack8(o0, o1);
    }
};
struct DftPre { f32x4 c[4]; };
struct EpiDft : EpiBase {
    typedef DftPre Pre; static constexpr int MB = 2;
    unsigned char* ws;
    __device__ __forceinline__ void load(const Unit& u, int lrow, int colq, DftPre& q) {
        const float* p = (const float*)(ws + WS_U1024) + u.aux * 512 + u.c0 + colq;
        q.c[0] = *(const f32x4*)p; q.c[1] = *(const f32x4*)(p + 4); q.c[2] = *(const f32x4*)(p + 32); q.c[3] = *(const f32x4*)(p + 36);
    }
    __device__ __forceinline__ void pair8(const Unit& u, int lrow, int colq, f32x4 a0, f32x4 a1, f32x4 b0, f32x4 b1, const DftPre& q) {
        const int row = u.r0 + lrow, pos = row & 2047; if (pos == 1024) return;
        if (pos < 1024) { const float sg = (pos & 1) ? -1.f : 1.f; a0 += sg * q.c[0]; a1 += sg * q.c[1]; b0 += sg * q.c[2]; b1 += sg * q.c[3]; }
        bf16_t* p = (bf16_t*)(ws + WS_R) + (size_t)row * 512 + u.c0 + colq; *(u32x4*)p = pack8(a0, a1); *(u32x4*)(p + 32) = pack8(b0, b1);
    }
};
struct EpiScan : EpiBase {
    static constexpr bool AFTER_DRAIN = true;
    unsigned char* ws; LAS float* ebuf;
    __device__ __forceinline__ void pair8(const Unit&, int lrow, int colq, f32x4 a0, f32x4 a1, f32x4 b0, f32x4 b1, const Pre&) {
        LAS float* p = ebuf + (lrow & 127) * 260 + colq; *(LAS f32x4*)p = a0; *(LAS f32x4*)(p + 4) = a1; *(LAS f32x4*)(p + 32) = b0; *(LAS f32x4*)(p + 36) = b1;
    }
    __device__ __forceinline__ void half_done(const Unit& u, int ai) {
        LDS_WAIT(); __syncthreads();
        const int tid = threadIdx.x;
        if (tid < 256) {
            const int dir = tid >> 7, part = (tid >> 6) & 1, p = tid & 63, g = u.aux;
            const f32x2 aL = ((const f32x2*)(ws + WS_AL))[(g * 2 + dir) * 64 + p];
            const int seq = (u.r0 >> 7) + ai;
            bf16_t* xrow = (bf16_t*)(ws + WS_XS) + ((size_t)g * 2048 + seq * 128) * 512 + 256 + tid;
            const LAS float* e = ebuf + dir * 128 + p;
            float sr = 0.f, si = 0.f;
            for (int blk = 0; blk < 8; ++blk) {
                float er[16], ei[16];
#pragma unroll
                for (int j = 0; j < 16; ++j) { const int c = dir ? 127 - (blk * 16 + j) : blk * 16 + j; er[j] = e[c * 260]; ei[j] = e[c * 260 + 64]; }
#pragma unroll
                for (int j = 0; j < 16; ++j) { const int c = dir ? 127 - (blk * 16 + j) : blk * 16 + j;
                    const float o = part ? si : sr;
                    xrow[(size_t)c * 512] = (bf16_t)(cvt_pk_bf16(o, 0.f) & 0xffffu);
                    const float nr = aL.x * sr - aL.y * si + er[j], ni = aL.x * si + aL.y * sr + ei[j];
                    sr = nr; si = ni; }
            }
        }
        __syncthreads();
    }
};
struct EpiYS : EpiBase {
    unsigned char* ws;
    __device__ __forceinline__ void pair8(const Unit& u, int lrow, int colq, f32x4 a0, f32x4 a1, f32x4 b0, f32x4 b1, const Pre&) {
        const int idx = u.r0 + lrow, b = idx >> 7, c = idx & 127;
#pragma unroll
        for (int bj = 0; bj < 2; ++bj) { const int col = colq + bj * 32, i = col >> 4, h = col & 15; f32x4 lo = bj ? b0 : a0, hi = bj ? b1 : a1;
#pragma unroll
            for (int q = 0; q < 4; ++q) { lo[q] = gelu_tanh(lo[q]); hi[q] = gelu_tanh(hi[q]); }
            bf16_t* p = (bf16_t*)(ws + WS_YS) + (size_t)(b * 2048 + c * 16 + i) * 512 + u.aux * 16 + h; *(u32x4*)p = pack8(lo, hi); }
    }
};
struct EpiFnet : EpiBase {
    bf16_t* O;
    __device__ __forceinline__ void pair8(const Unit& u, int lrow, int colq, f32x4 a0, f32x4 a1, f32x4 b0, f32x4 b1, const Pre&) {
        const int row = u.r0 + lrow; if ((row & 2047) == 1024) return;
        bf16_t* p = O + (size_t)row * 1024 + u.c0 + colq; *(u32x4*)p = pack8(a0, a1); *(u32x4*)(p + 32) = pack8(b0, b1);
    }
};
struct EpiP1All : EpiBase {
    unsigned char* ws;
    __device__ __forceinline__ void pair8(const Unit& u, int lrow, int colq, f32x4 a0, f32x4 a1, f32x4 b0, f32x4 b1, const Pre& p) {
        if (u.sub == 0) { EpiP1Main E; E.ws = ws; E.pair8(u, lrow, colq, a0, a1, b0, b1, p); } else { EpiP1Swap E; E.ws = ws; E.pair8(u, lrow, colq, a0, a1, b0, b1, p); }
    }
};
struct EpiP3All : EpiBase {
    unsigned char* ws; bf16_t* Y;
    __device__ __forceinline__ void pair8(const Unit& u, int lrow, int colq, f32x4 a0, f32x4 a1, f32x4 b0, f32x4 b1, const Pre& p) {
        if (u.sub == 0) { EpiYS E; E.ws = ws; E.pair8(u, lrow, colq, a0, a1, b0, b1, p); } else { EpiFnet E; E.O = Y; E.pair8(u, lrow, colq, a0, a1, b0, b1, p); }
    }
};
struct EpiGluM : EpiBase {
    static constexpr bool WHOLE_TILE = true;
    unsigned char* ws; const bf16_t* Y;
    __device__ __forceinline__ void pair8(const Unit&, int, int, f32x4, f32x4, f32x4, f32x4, const Pre&) {}
    __device__ __forceinline__ void tile(f32x4 (&acc)[2][2][4][2], const Unit& u, int wr, int wc, int fr, int fq) {
        const int oc = u.c0 + wc * 32 + fq * 8;
        u32x4 y1[4], y2[4]; u32x2 za[4][2], zb[4][2];
#pragma unroll
        for (int m = 0; m < 4; ++m) { const int k = u.aux * 128 + wr * 64 + m * 16 + fr, tA = u.r0 + k, tB = u.r0 + (k == 0 ? 1024 : 2048 - k);
            y1[m] = *(const u32x4*)(Y + (size_t)tA * 1024 + oc); y2[m] = *(const u32x4*)(Y + (size_t)(tA + 1024) * 1024 + oc);
            za[m][0] = *(const u32x2*)(ws + WS_ZA + (size_t)tA * 1024 + oc); zb[m][0] = *(const u32x2*)(ws + WS_ZB + (size_t)tA * 1024 + oc);
            za[m][1] = *(const u32x2*)(ws + WS_ZA + (size_t)tB * 1024 + oc); zb[m][1] = *(const u32x2*)(ws + WS_ZB + (size_t)tB * 1024 + oc); }
#pragma unroll
        for (int m = 0; m < 4; ++m) { const int k = u.aux * 128 + wr * 64 + m * 16 + fr, tA = u.r0 + k, tB = u.r0 + (k == 0 ? 1024 : 2048 - k);
            const f32x4 p_lo = unpack_lo(y1[m]), p_hi = unpack_hi(y1[m]), q_lo = unpack_lo(y2[m]), q_hi = unpack_hi(y2[m]);
            const f32x4 ybA_lo = k == 0 ? p_lo : p_lo - q_lo, ybA_hi = k == 0 ? p_hi : p_hi - q_hi, ybB_lo = k == 0 ? q_lo : p_lo + q_lo, ybB_hi = k == 0 ? q_hi : p_hi + q_hi;
            const f32x4 a_lo = dq8x4(za[m][0].x) * (acc[0][0][m][0] * sigmoid4(acc[0][1][m][0])) + dq8x4(zb[m][0].x) * ybA_lo;
            const f32x4 a_hi = dq8x4(za[m][0].y) * (acc[0][0][m][1] * sigmoid4(acc[0][1][m][1])) + dq8x4(zb[m][0].y) * ybA_hi;
            *(u32x4*)((bf16_t*)(ws + WS_MG) + (size_t)tA * 1024 + oc) = pack8(a_lo, a_hi);
            const f32x4 b_lo = dq8x4(za[m][1].x) * (acc[1][0][m][0] * sigmoid4(acc[1][1][m][0])) + dq8x4(zb[m][1].x) * ybB_lo;
            const f32x4 b_hi = dq8x4(za[m][1].y) * (acc[1][0][m][1] * sigmoid4(acc[1][1][m][1])) + dq8x4(zb[m][1].y) * ybB_hi;
            *(u32x4*)((bf16_t*)(ws + WS_MG) + (size_t)tB * 1024 + oc) = pack8(b_lo, b_hi); }
    }
};
struct ResPre0 { u32x4 a, b; float s; };
struct ResPre1 { u32x4 a, b; };
template <int WHICH> struct EpiRes : EpiBase {
    typedef typename std::conditional<WHICH == 0, ResPre0, ResPre1>::type Pre; static constexpr int MB = 4;
    const float* x; unsigned char* ws; float ss;
    __device__ __forceinline__ void load(const Unit& u, int lrow, int colq, Pre& q) {
        const size_t off = (size_t)(u.r0 + lrow) * 1024 + u.c0 + colq;
        if constexpr (WHICH == 0) { const bf16_t* xn = (const bf16_t*)(ws + WS_XN) + off; q.a = *(const u32x4*)xn; q.b = *(const u32x4*)(xn + 32); q.s = ((const float*)(ws + WS_INVR))[u.r0 + lrow]; }
        else { const bf16_t* xb = (const bf16_t*)(ws + WS_XB) + off; q.a = *(const u32x4*)xb; q.b = *(const u32x4*)(xb + 32); }
    }
    __device__ __forceinline__ void row_begin() { ss = 0.f; }
    __device__ __forceinline__ void pair8(const Unit& u, int lrow, int colq, f32x4 a0, f32x4 a1, f32x4 b0, f32x4 b1, const Pre& q) {
        const size_t off = (size_t)(u.r0 + lrow) * 1024 + u.c0 + colq;
        if constexpr (WHICH == 0) { a0 += unpack_lo(q.a) * q.s; a1 += unpack_hi(q.a) * q.s; b0 += unpack_lo(q.b) * q.s; b1 += unpack_hi(q.b) * q.s; } else { a0 += unpack_lo(q.a); a1 += unpack_hi(q.a); b0 += unpack_lo(q.b); b1 += unpack_hi(q.b); }
        bf16_t* xb = (bf16_t*)(ws + WS_XB) + off; *(u32x4*)xb = pack8(a0, a1); *(u32x4*)(xb + 32) = pack8(b0, b1);
        const f32x4 s4 = a0 * a0 + a1 * a1 + b0 * b0 + b1 * b1; ss += (s4[0] + s4[1]) + (s4[2] + s4[3]);
    }
    __device__ __forceinline__ void row_end(const Unit& u, int lrow, int slot, int nslots) {
        float s = ss; s += __shfl_xor(s, 16); s += __shfl_xor(s, 32);
        if ((threadIdx.x & 63) < 16) { float* p = (float*)(ws + (WHICH ? WS_SSP2 : WS_SSP1)) + (size_t)(u.r0 + lrow) * 16 + (u.c0 >> 8) * 4;
            if (nslots == 1) *(f32x4*)p = (f32x4){s, 0.f, 0.f, 0.f}; else p[slot] = s; }
    }
};
struct EpiUp : EpiBase {
    unsigned char* ws; const LAS float* rs; bf16_t* hlo;
    __device__ __forceinline__ void pair8(const Unit& u, int lrow, int colq, f32x4 a0, f32x4 a1, f32x4 b0, f32x4 b1, const Pre&) {
        const float r = rs[u.slot * 256 + lrow];
        a0 *= r; a1 *= r; b0 *= r; b1 *= r;
#pragma unroll
        for (int j = 0; j < 4; ++j) { a0[j] = a0[j] > 0.f ? a0[j] * a0[j] : 0.f; a1[j] = a1[j] > 0.f ? a1[j] * a1[j] : 0.f; b0[j] = b0[j] > 0.f ? b0[j] * b0[j] : 0.f; b1[j] = b1[j] > 0.f ? b1[j] * b1[j] : 0.f; }
        bf16_t* p = (u.c0 < 2048 ? hlo + u.c0 : (bf16_t*)(ws + WS_HHI) + (u.c0 - 2048)) + (size_t)(u.r0 + lrow) * 2048 + colq; *(u32x4*)p = pack8(a0, a1); *(u32x4*)(p + 32) = pack8(b0, b1);
    }
};
struct EpiFinal : EpiBase {
    static constexpr bool WHOLE_TILE = true;
    unsigned char* ws; float* out; const LAS float* rs; const float* gfin;
    __device__ __forceinline__ void pair8(const Unit&, int, int, f32x4, f32x4, f32x4, f32x4, const Pre&) {}
    __device__ __forceinline__ void tile(f32x4 (&acc)[2][2][4][2], const Unit& u, int wr, int wc, int fr, int fq) {
        float* ss3 = (float*)(ws + WS_CTL + CTL_SS3); unsigned* cnt = (unsigned*)(ws + WS_CTL + CTL_CNT) + (u.r0 >> 8) * 64;
        const int colb = u.c0 + wc * 64 + fq * 8;
        u32x4 pk[2][4][2];
#pragma unroll
        for (int ai = 0; ai < 2; ++ai)
#pragma unroll
            for (int m = 0; m < 4; ++m) {
                const int lrow = ai * 128 + wr * 64 + m * 16 + fr; const size_t off = (size_t)(u.r0 + lrow) * 1024 + colb;
                const bf16_t* xb = (const bf16_t*)(ws + WS_XB) + off; const bf16_t* pp = (const bf16_t*)(ws + WS_PP) + off;
                const u32x4 x0 = *(const u32x4*)xb, x1 = *(const u32x4*)(xb + 32), p0 = *(const u32x4*)pp, p1 = *(const u32x4*)(pp + 32);
                const float r = rs[u.slot * 256 + lrow];
                const f32x4 a0 = unpack_lo(x0) + sigmoid4(acc[ai][0][m][0] * r) * unpack_lo(p0), a1 = unpack_hi(x0) + sigmoid4(acc[ai][0][m][1] * r) * unpack_hi(p0);
                const f32x4 b0 = unpack_lo(x1) + sigmoid4(acc[ai][1][m][0] * r) * unpack_lo(p1), b1 = unpack_hi(x1) + sigmoid4(acc[ai][1][m][1] * r) * unpack_hi(p1);
                pk[ai][m][0] = pack8(a0, a1); pk[ai][m][1] = pack8(b0, b1);
                const f32x4 s4 = a0 * a0 + a1 * a1 + b0 * b0 + b1 * b1; float s = (s4[0] + s4[1]) + (s4[2] + s4[3]);
                s += __shfl_xor(s, 16); s += __shfl_xor(s, 32);
                if (fq == 0) (void)__hip_atomic_fetch_add(ss3 + u.r0 + lrow, s, __ATOMIC_RELAXED, __HIP_MEMORY_SCOPE_AGENT);
                asm volatile("" ::: "memory");
            }
        asm volatile("s_waitcnt vmcnt(0)" ::: "memory");
        if ((threadIdx.x & 63) == 0) (void)__hip_atomic_fetch_add(cnt, 1u, __ATOMIC_RELAXED, __HIP_MEMORY_SCOPE_AGENT);
        { unsigned sp = 0; while ((unsigned)__builtin_amdgcn_readfirstlane(__hip_atomic_load(cnt, __ATOMIC_RELAXED, __HIP_MEMORY_SCOPE_AGENT)) < 32u) { __builtin_amdgcn_s_sleep(2); if (++sp > (1u << 22)) break; } }
        f32x4 gv[2][2];
#pragma unroll
        for (int bj = 0; bj < 2; ++bj)
#pragma unroll
            for (int n = 0; n < 2; ++n) gv[bj][n] = *(const f32x4*)(gfin + colb + bj * 32 + n * 4);
#pragma unroll
        for (int ai = 0; ai < 2; ++ai)
#pragma unroll
            for (int m = 0; m < 4; ++m) { const int row = u.r0 + ai * 128 + wr * 64 + m * 16 + fr;
                const float tot = __hip_atomic_load(ss3 + row, __ATOMIC_RELAXED, __HIP_MEMORY_SCOPE_AGENT), rstd = 1.0f / sqrtf(tot * (1.0f / D) + EPS);
                float* o = out + (size_t)row * 1024 + colb;
                *(f32x4*)o = unpack_lo(pk[ai][m][0]) * rstd * gv[0][0]; *(f32x4*)(o + 4) = unpack_hi(pk[ai][m][0]) * rstd * gv[0][1];
                *(f32x4*)(o + 32) = unpack_lo(pk[ai][m][1]) * rstd * gv[1][0]; *(f32x4*)(o + 36) = unpack_hi(pk[ai][m][1]) * rstd * gv[1][1]; }
    }
};

__device__ __forceinline__ int perm32(int rho) { const int n = rho >> 4, i = rho & 15; return 8 * (i >> 2) + 4 * n + (i & 3); }
template <class Epi, class SegT>
__device__ __forceinline__ void gemm_simple(const SegT& S, Epi& E) {
    const int tid = threadIdx.x, wave = __builtin_amdgcn_readfirstlane(tid >> 6), lane = tid & 63, fr = lane & 15, fq = lane >> 4;
    constexpr int lda = SegT::lda(), ldb = SegT::ldb(), K = SegT::K();
    static_assert(!SegT::CUSTOMA && !SegT::SPLITA && !Epi::WHOLE_TILE, "the simple body has no mirrored-row staging and no whole-tile epilogue: run this segment on the fast body");
    Unit u;
    for (int i = 0; S.next(i, u); ++i) {
        for (int ai = 0; ai < 2; ++ai) {
            const int lrow = ai * 128 + wave * 16 + fr;
            const bf16_t* ap = u.A + (size_t)lrow * lda + fq * 8;
            E.row_begin();
            for (int wc = 0; wc < 4; ++wc) {
                f32x4 acc[2][2];
#pragma unroll
                for (int bj = 0; bj < 2; ++bj)
#pragma unroll
                    for (int n = 0; n < 2; ++n) {
                        int brow = wc * 64 + bj * 32 + perm32(n * 16 + fr);
                        if constexpr (SegT::CUSTOMB) { const int pos = u.c0 + wc * 32 + perm32(n * 16 + fr); brow = bj ? (pos == 0 ? 1024 : 2048 - pos) : pos; }
                        const bf16_t* bp = u.B + (size_t)brow * ldb + fq * 8;
                        f32x4 a = {0.f, 0.f, 0.f, 0.f};
#pragma unroll 4
                        for (int k = 0; k < K; k += 32) a = __builtin_amdgcn_mfma_f32_16x16x32_bf16(*(const bf16x8*)(bp + k), *(const bf16x8*)(ap + k), a, 0, 0, 0);
                        acc[bj][n] = a;
                    }
                typename Epi::Pre pre; E.load(u, lrow, wc * 64 + fq * 8, pre);
                E.pair8(u, lrow, wc * 64 + fq * 8, acc[0][0], acc[0][1], acc[1][0], acc[1][1], pre);
            }
            E.row_end(u, lrow, 0, 1);
            E.half_done(u, ai);
        }
    }
}

constexpr int BM = 256, BK = 64, HALF = 128, HTB = HALF * BK * 2;
__device__ __forceinline__ int lds_byte(int r, int c) { const int st = (r >> 4) * 2 + (c >> 5), rr = r & 15, cc = c & 31, ob = rr * 64 + cc * 2; return st * 1024 + (ob ^ (((ob >> 9) & 1) << 5)); }
__device__ __forceinline__ void stage_rc(int b, int& R, int& C) { const int st = b / 1024, sb = b % 1024, swz = sb ^ (((sb >> 9) & 1) << 5); R = (st >> 1) * 16 + swz / 64; C = (st & 1) * 32 + (swz % 64) / 2; }

#ifndef PG8_ALIGN
#define PG8_ALIGN true
#endif
#ifndef PG8_SP2
#define PG8_SP2 true
#endif
struct NoHook { __device__ __forceinline__ void operator()() const {} };
template <class Epi, class SegT, class Hook = NoHook, bool ALIGN_EPI = PG8_ALIGN, bool SP2 = PG8_SP2>
__device__ __forceinline__ void gemm_fast(LAS unsigned char* lds, const SegT& S, Epi& E, const Hook& hook = Hook()) {
    const int tid = threadIdx.x, wid = __builtin_amdgcn_readfirstlane(tid >> 6), lane = tid & 63, wr = wid >> 2, wc = wid & 3, fr = lane & 15, fq = lane >> 4;
    constexpr int lda = SegT::lda(), ldb = SegT::ldb(), K = SegT::K(), nt = K / BK;
    unsigned voffA[2], voffB0[2], voffB1[2];
#pragma unroll
    for (int i = 0; i < 2; ++i) { int R, C; stage_rc(tid * 16 + i * 8192, R, C); voffA[i] = (unsigned)(R * lda + C) * 2u;
        const int Rb = (R >> 5) * 64 + perm32(R & 31); voffB0[i] = (unsigned)(Rb * ldb + C) * 2u; voffB1[i] = (unsigned)((Rb + 32) * ldb + C) * 2u; }
    constexpr size_t kstep = (size_t)(BK * 2);
    constexpr size_t hstepA = (size_t)HALF * lda * 2;
    int voffAh[2], voffAhS[2];
#pragma unroll
    for (int i = 0; i < 2; ++i) { int R, C; stage_rc(tid * 16 + i * 8192, R, C); voffAh[i] = ((127 - R) * lda + C) * 2; voffAhS[i] = voffAh[i] - (R == 0 ? 1024 * lda * 2 : 0); }
#define PG8_STAGE_AH(bufoff, base_lo, base_hi, special) do { if constexpr (SegT::CUSTOMA) { _Pragma("unroll") for (int _i = 0; _i < 2; ++_i) \
        __builtin_amdgcn_global_load_lds((const unsigned*)((const char*)(base_hi) + (long)((special) ? voffAhS[_i] : voffAh[_i])), (LAS unsigned*)(lds + (bufoff) + ldsw + _i * 8192), 16, 0, 0); } \
        else { PG8_STAGE(bufoff, (const char*)(base_lo) + hstepA, voffA); } } while (0)
    const unsigned ldsw = (unsigned)wid * 1024u;
    const int aoff = lds_byte(wr * 64 + fr, fq * 8), boff = lds_byte(wc * 32 + fr, fq * 8);
#define PG8_SA(b, h) (((b) * 2 + (h)) * HTB)
#define PG8_SB(b, h) ((4 + (b) * 2 + (h)) * HTB)
#define PG8_STAGE(bufoff, gbase, voff) do { _Pragma("unroll") for (int _i = 0; _i < 2; ++_i) \
        __builtin_amdgcn_global_load_lds((const unsigned*)((const char*)(gbase) + (voff)[_i]), (LAS unsigned*)(lds + (bufoff) + ldsw + _i * 8192), 16, 0, 0); } while (0)
#define PG8_LDA(dst, b, h) do { _Pragma("unroll") for (int m = 0; m < 4; ++m) _Pragma("unroll") for (int k = 0; k < 2; ++k) dst[m][k] = *(const LAS bf16x8*)(lds + PG8_SA(b, h) + aoff + m * 2048 + k * 1024); } while (0)
#define PG8_LDB(dst, b, h) do { _Pragma("unroll") for (int n = 0; n < 2; ++n) _Pragma("unroll") for (int k = 0; k < 2; ++k) dst[n][k] = *(const LAS bf16x8*)(lds + PG8_SB(b, h) + boff + n * 2048 + k * 1024); } while (0)
#define PG8_MMA(ai, bj, At, Bt) do { __builtin_amdgcn_s_setprio(1); _Pragma("unroll") for (int m = 0; m < 4; ++m) _Pragma("unroll") for (int n = 0; n < 2; ++n) _Pragma("unroll") for (int k = 0; k < 2; ++k) \
        acc[ai][bj][m][n] = __builtin_amdgcn_mfma_f32_16x16x32_bf16(Bt[n][k], At[m][k], acc[ai][bj][m][n], 0, 0, 0); __builtin_amdgcn_s_setprio(0); } while (0)
#define PG8_WAIT_V(n) asm volatile("s_waitcnt vmcnt(" #n ")" ::: "memory")
#define PG8_WAIT_L(n) asm volatile("s_waitcnt lgkmcnt(" #n ")" ::: "memory")
#define PG8_BAR __builtin_amdgcn_s_barrier()
#define PG8_SCHED __builtin_amdgcn_sched_barrier(0)
#define PG8_EPILOGUE() do { if constexpr (Epi::WHOLE_TILE) { static_assert(!Epi::WHOLE_TILE || ALIGN_EPI, "the exchange in a whole-tile epilogue needs both half-workgroups in the epilogue together"); E.tile(acc, cur, wr, wc, fr, fq); } else { _Pragma("unroll") for (int ai = 0; ai < 2; ++ai) { _Pragma("unroll") for (int mb = 0; mb < 4; mb += Epi::MB) { typename Epi::Pre pre[Epi::MB]; \
        _Pragma("unroll") for (int mm = 0; mm < Epi::MB; ++mm) E.load(cur, ai * HALF + wr * 64 + (mb + mm) * 16 + fr, wc * 64 + fq * 8, pre[mm]); \
        _Pragma("unroll") for (int mm = 0; mm < Epi::MB; ++mm) { const int lrow = ai * HALF + wr * 64 + (mb + mm) * 16 + fr; E.row_begin(); \
            E.pair8(cur, lrow, wc * 64 + fq * 8, acc[ai][0][mb + mm][0], acc[ai][0][mb + mm][1], acc[ai][1][mb + mm][0], acc[ai][1][mb + mm][1], pre[mm]); E.row_end(cur, lrow, wc, 4); } } E.half_done(cur, ai); } } } while (0)
    Unit cur, nxt; int ui = 0;
    if (!S.next(0, cur)) return;
    if constexpr (SegT::CUSTOMB) {
#pragma unroll
        for (int i = 0; i < 2; ++i) { int R, C; stage_rc(tid * 16 + i * 8192, R, C); const int pos = cur.c0 + (R >> 5) * 32 + perm32(R & 31), mir = pos == 0 ? 1024 : 2048 - pos;
            voffB0[i] = (unsigned)(pos * ldb + C) * 2u; voffB1[i] = (unsigned)(mir * ldb + C) * 2u; }
    }
    f32x4 acc[2][2][4][2];
#pragma unroll
    for (int a = 0; a < 2; ++a)
#pragma unroll
        for (int b = 0; b < 2; ++b)
#pragma unroll
            for (int m = 0; m < 4; ++m)
#pragma unroll
                for (int n = 0; n < 2; ++n) acc[a][b][m][n] = (f32x4){0.f, 0.f, 0.f, 0.f};
    bf16x8 At[4][2], B0[2][2], B1[2][2];
    const char* cA = (const char*)cur.A; const char* cB = (const char*)cur.B; const char* cA2 = SegT::CUSTOMA ? (const char*)cur.A2 : cA;
    const char* cAhi = SegT::SPLITA ? (const char*)cur.A2 - (size_t)(nt / 2) * (size_t)(BK * 2) : cA;
    if constexpr (SP2) {
        PG8_STAGE(PG8_SB(0, 0), cB, voffB0); PG8_STAGE(PG8_SB(0, 1), cB, voffB1); PG8_STAGE(PG8_SA(0, 0), cA, voffA); PG8_STAGE_AH(PG8_SA(0, 1), cA, cA2, cur.sub != 0);
        hook();
        if (wr == 1) PG8_BAR;
        PG8_WAIT_V(2); PG8_BAR;
        PG8_STAGE(PG8_SB(1, 0), cB + kstep, voffB0); PG8_STAGE(PG8_SA(1, 0), cA + kstep, voffA); PG8_STAGE(PG8_SB(1, 1), cB + kstep, voffB1);
        PG8_WAIT_V(6); PG8_BAR;
    } else {
        PG8_STAGE(PG8_SB(0, 0), cB, voffB0); PG8_STAGE(PG8_SA(0, 0), cA, voffA); PG8_STAGE(PG8_SB(0, 1), cB, voffB1); PG8_STAGE_AH(PG8_SA(0, 1), cA, cA2, cur.sub != 0);
        if (wr == 1) PG8_BAR;
        PG8_WAIT_V(4); PG8_BAR;
        PG8_STAGE(PG8_SB(1, 0), cB + kstep, voffB0); PG8_STAGE(PG8_SA(1, 0), cA + kstep, voffA); PG8_STAGE(PG8_SB(1, 1), cB + kstep, voffB1);
        PG8_WAIT_V(6); PG8_BAR;
    }
    for (;;) {
        const bool has_next = S.next(ui + 1, nxt);
        const char* nA = has_next ? (const char*)nxt.A : cA; const char* nB = has_next ? (const char*)nxt.B : cB;
        const char* nA2 = SegT::CUSTOMA ? (has_next ? (const char*)nxt.A2 : cA2) : nA; const bool nsub = has_next ? (nxt.sub != 0) : (cur.sub != 0);
        const char* nAhi = SegT::SPLITA ? (has_next ? (const char*)nxt.A2 - (size_t)(nt / 2) * (size_t)(BK * 2) : cAhi) : nA;
        _Pragma("nounroll") for (int t = 0; t < nt; t += 2) {
            const bool last = (t == nt - 2);
            const char* sd0 = (SegT::SPLITA && t >= nt / 2) ? cAhi : cA; const char* sd2 = (SegT::SPLITA && t + 2 >= nt / 2) ? cAhi : cA;
            const char* a1 = sd0 + (size_t)(t + 1) * kstep;
            const char* a2 = last ? nA : sd2 + (size_t)(t + 2) * kstep; const char* b2 = last ? nB : cB + (size_t)(t + 2) * kstep;
            const char* a3 = a2 + kstep; const char* b3 = b2 + kstep;
            const char* a1h = cA2 + (size_t)(t + 1) * kstep; const char* a2h = last ? nA2 : cA2 + (size_t)(t + 2) * kstep; const bool s1 = cur.sub != 0, s2 = last ? nsub : (cur.sub != 0);
            if constexpr (SP2) {
            PG8_LDB(B0, 0, 0); PG8_LDB(B1, 0, 1); PG8_SCHED; PG8_LDA(At, 0, 0); PG8_STAGE_AH(PG8_SA(1, 1), a1, a1h, s1);
            PG8_WAIT_V(8); PG8_WAIT_L(0); PG8_BAR; PG8_MMA(0, 0, At, B0); PG8_MMA(0, 1, At, B1); PG8_BAR; PG8_SCHED;
            PG8_LDA(At, 0, 1); PG8_STAGE(PG8_SB(0, 0), b2, voffB0); PG8_STAGE(PG8_SB(0, 1), b2, voffB1); PG8_STAGE(PG8_SA(0, 0), a2, voffA);
            PG8_WAIT_V(8); PG8_WAIT_L(0); PG8_BAR; PG8_MMA(1, 0, At, B0); PG8_MMA(1, 1, At, B1); PG8_BAR; PG8_SCHED;
            PG8_LDB(B0, 1, 0); PG8_LDB(B1, 1, 1); PG8_SCHED; PG8_LDA(At, 1, 0); PG8_STAGE_AH(PG8_SA(0, 1), a2, a2h, s2);
            PG8_WAIT_V(8); PG8_WAIT_L(0); PG8_BAR; PG8_MMA(0, 0, At, B0); PG8_MMA(0, 1, At, B1); PG8_BAR; PG8_SCHED;
            PG8_LDA(At, 1, 1); PG8_STAGE(PG8_SB(1, 0), b3, voffB0); PG8_STAGE(PG8_SB(1, 1), b3, voffB1); PG8_STAGE(PG8_SA(1, 0), a3, voffA);
            PG8_WAIT_V(8); PG8_WAIT_L(0); PG8_BAR; PG8_MMA(1, 0, At, B0); PG8_MMA(1, 1, At, B1); PG8_BAR; PG8_SCHED;
            } else {
            PG8_LDB(B0, 0, 0); PG8_SCHED; PG8_LDA(At, 0, 0); PG8_STAGE_AH(PG8_SA(1, 1), a1, a1h, s1);
            PG8_WAIT_L(8); PG8_BAR; PG8_WAIT_L(0); PG8_MMA(0, 0, At, B0); PG8_BAR; PG8_SCHED;
            PG8_LDB(B1, 0, 1); PG8_STAGE(PG8_SB(0, 0), b2, voffB0);
            PG8_BAR; PG8_WAIT_L(0); PG8_MMA(0, 1, At, B1); PG8_BAR;
            PG8_LDA(At, 0, 1); PG8_STAGE(PG8_SA(0, 0), a2, voffA);
            PG8_BAR; PG8_WAIT_L(0); PG8_MMA(1, 0, At, B0); PG8_BAR; PG8_SCHED;
            PG8_STAGE(PG8_SB(0, 1), b2, voffB1);
            PG8_WAIT_V(6); PG8_BAR; PG8_MMA(1, 1, At, B1); PG8_BAR;
            PG8_LDB(B0, 1, 0); PG8_SCHED; PG8_LDA(At, 1, 0); PG8_STAGE_AH(PG8_SA(0, 1), a2, a2h, s2);
            PG8_WAIT_L(8); PG8_BAR; PG8_WAIT_L(0); PG8_MMA(0, 0, At, B0); PG8_BAR; PG8_SCHED;
            PG8_LDB(B1, 1, 1); PG8_STAGE(PG8_SB(1, 0), b3, voffB0);
            PG8_BAR; PG8_WAIT_L(0); PG8_MMA(0, 1, At, B1); PG8_BAR;
            PG8_LDA(At, 1, 1); PG8_STAGE(PG8_SA(1, 0), a3, voffA);
            PG8_BAR; PG8_WAIT_L(0); PG8_MMA(1, 0, At, B0); PG8_BAR; PG8_SCHED;
            PG8_STAGE(PG8_SB(1, 1), b3, voffB1);
            PG8_WAIT_V(6); PG8_BAR; PG8_MMA(1, 1, At, B1); PG8_BAR;
            }
        }
        if constexpr (ALIGN_EPI) { if (wr == 0) PG8_BAR; }
        if constexpr (!Epi::AFTER_DRAIN) { PG8_EPILOGUE(); }
        if (!has_next) break;
#pragma unroll
        for (int a = 0; a < 2; ++a)
#pragma unroll
            for (int b = 0; b < 2; ++b)
#pragma unroll
                for (int m = 0; m < 4; ++m)
#pragma unroll
                    for (int n = 0; n < 2; ++n) acc[a][b][m][n] = (f32x4){0.f, 0.f, 0.f, 0.f};
        cur = nxt; cA = nA; cB = nB; cA2 = nA2; cAhi = nAhi; ++ui;
        if constexpr (ALIGN_EPI) { if (wr == 1) PG8_BAR; }
    }
    PG8_WAIT_V(0);
    if constexpr (!ALIGN_EPI) { if (wr == 0) PG8_BAR; }
    PG8_BAR;
    if constexpr (Epi::AFTER_DRAIN) { PG8_EPILOGUE(); }
#undef PG8_SA
#undef PG8_SB
#undef PG8_STAGE
#undef PG8_STAGE_AH
#undef PG8_LDA
#undef PG8_LDB
#undef PG8_MMA
#undef PG8_WAIT_V
#undef PG8_WAIT_L
#undef PG8_BAR
#undef PG8_SCHED
#undef PG8_EPILOGUE
}

template <int KIND, class Epi, class Hook = NoHook>
__device__ __forceinline__ void run_segment(LAS unsigned char* lds, unsigned char* ws, int G, Epi& E, const Hook& hook = Hook(), const void* ext = nullptr) {
    Seg<KIND> S; S.ws = ws; S.G = G; S.c = blockIdx.x; S.only = -1; S.ext = ext;
    if constexpr ((FAST_MASK >> KIND) & 1) {
        if constexpr (Epi::AFTER_DRAIN || Seg<KIND>::CUSTOMB) { hook(); const int n = S.count(); for (int i = 0; i < n; ++i) { S.only = i; gemm_fast<Epi, Seg<KIND>>(lds, S, E); } }
        else gemm_fast<Epi, Seg<KIND>, Hook>(lds, S, E, hook);
        __syncthreads();
    } else {
        hook(); gemm_simple<Epi, Seg<KIND>>(S, E);
    }
}

__device__ __forceinline__ void transpose_item(const float* W, int K, int N, bf16_t* WT, const float* gk, int glu_map, LAS float* scr, int item, int lane) {
    const int nblk = N / 32, kb = item / nblk, nb = item % nblk, k0 = 64 * kb, n0 = 32 * nb;
    float tv[32];
#pragma unroll
    for (int i = 0; i < 32; ++i) { const int kk = 2 * i + (lane >> 5); tv[i] = W[(size_t)(k0 + kk) * N + n0 + (lane & 31)]; }
#pragma unroll
    for (int i = 0; i < 32; ++i) { const int kk = 2 * i + (lane >> 5); float v = tv[i]; if (gk) v *= gk[k0 + kk]; scr[kk * 33 + (lane & 31)] = v; }
    LDS_WAIT(); asm volatile("" ::: "memory");
    int d0 = n0;
    if (glu_map) { const int v = n0 < 1024 ? n0 : n0 - 1024; d0 = (v >> 7) * 256 + ((v >> 5) & 3) * 64 + (n0 < 1024 ? 0 : 32); }
    const int c = lane & 7;
#pragma unroll
    for (int j = 0; j < 4; ++j) { const int n = (lane >> 3) + 8 * j; const LAS float* s = scr + (8 * c) * 33 + n;
        u32x4 o; o.x = cvt_pk_bf16(s[0 * 33], s[1 * 33]); o.y = cvt_pk_bf16(s[2 * 33], s[3 * 33]); o.z = cvt_pk_bf16(s[4 * 33], s[5 * 33]); o.w = cvt_pk_bf16(s[6 * 33], s[7 * 33]);
        *(u32x4*)(WT + (size_t)(d0 + n) * K + k0 + 8 * c) = o; }
    LDS_WAIT(); asm volatile("" ::: "memory");
}

struct In { const float *x, *p, *g_mix, *w_in, *lam_re, *lam_im, *log_dt, *b_re, *b_im, *c_re, *c_im, *d_skip, *w_glu, *w_fnet, *w_out, *g_ffn, *w_up, *w_down, *g_ple, *w_ple_gate, *w_ple, *g_final; };

template <int NI>
__device__ __forceinline__ void s5_tables(const In& in, unsigned char* ws, LAS unsigned char* lds, int gp0, int gp1) {
    constexpr int ISZ = 17408 + 16384 + 16384 + 4096;
    const int tid = threadIdx.x;
    float s1_lr = 0.f, s1_li = 0.f, s1_ldt = 0.f;
    const int it1 = (tid >> 7) & (NI - 1), gp_1 = it1 ? gp1 : gp0;
    if (tid < 128 * NI) { const int t = tid & 127, d = t >> 6, p = t & 63, gi = d * 32 + (gp_1 >> 3); s1_lr = in.lam_re[gi * 64 + p]; s1_li = in.lam_im[gi * 64 + p]; s1_ldt = in.log_dt[gi]; }
    float p_lr[4 * NI], p_li[4 * NI], p_br[4 * NI], p_bi[4 * NI], p_cr[4 * NI], p_ci[4 * NI];
#pragma unroll
    for (int k = 0; k < 4 * NI; ++k) { const int g = ((k >> 2) ? gp1 : gp0) >> 3, el = tid + (k & 3) * NTHR;
        const int d = el >> 10, p = (el >> 4) & 63, h = el & 15, gi = d * 32 + g, h2 = (el >> 6) & 15, p2 = el & 63;
        p_lr[k] = in.lam_re[gi * 64 + p]; p_li[k] = in.lam_im[gi * 64 + p];
        p_br[k] = in.b_re[((size_t)gi * 64 + p) * 16 + h]; p_bi[k] = in.b_im[((size_t)gi * 64 + p) * 16 + h];
        p_cr[k] = in.c_re[((size_t)gi * 16 + h2) * 64 + p2]; p_ci[k] = in.c_im[((size_t)gi * 16 + h2) * 64 + p2]; }
    const float dsk00 = in.d_skip[(gp0 >> 3) * 16 + 2 * (gp0 & 7)], dsk01 = in.d_skip[(gp0 >> 3) * 16 + 2 * (gp0 & 7) + 1], dsk10 = in.d_skip[(gp1 >> 3) * 16 + 2 * (gp1 & 7)], dsk11 = in.d_skip[(gp1 >> 3) * 16 + 2 * (gp1 & 7) + 1];
    if (tid < 128 * NI) {
        LAS f32x2* apow = (LAS f32x2*)(lds + it1 * ISZ);
        const int t = tid & 127, d = t >> 6, p = t & 63, g = gp_1 >> 3;
        const float dt = expf(s1_ldt), mag = expf(s1_lr * dt), ar = mag * cosf(s1_li * dt), ai = mag * sinf(s1_li * dt);
        float zr = 1.f, zi = 0.f;
        for (int m = 0; m <= 16; ++m) { apow[(d * 17 + m) * 64 + p] = (f32x2){zr, zi}; const float nr = zr * ar - zi * ai; zi = zr * ai + zi * ar; zr = nr; }
        if ((gp_1 & 7) == 0) ((f32x2*)(ws + WS_AL))[(g * 2 + d) * 64 + p] = apow[(d * 17 + 16) * 64 + p];
    }
    __syncthreads();
#pragma unroll
    for (int k = 0; k < 4 * NI; ++k) { const int it = k >> 2, el = tid + (k & 3) * NTHR;
        LAS f32x2* apow = (LAS f32x2*)(lds + it * ISZ); LAS f32x2* bbar = (LAS f32x2*)(lds + it * ISZ + 17408); LAS f32x2* cc = (LAS f32x2*)(lds + it * ISZ + 17408 + 16384);
        const int d = el >> 10, p = (el >> 4) & 63, h = el & 15, h2 = (el >> 6) & 15, p2 = el & 63;
        const float lr = p_lr[k], li = p_li[k];
        const f32x2 a = apow[(d * 17 + 1) * 64 + p]; const float nr = a.x - 1.f, ni = a.y, den = 1.f / (lr * lr + li * li);
        const float qr = (nr * lr + ni * li) * den, qi = (ni * lr - nr * li) * den;
        bbar[(d * 64 + p) * 16 + h] = (f32x2){qr * p_br[k] - qi * p_bi[k], qr * p_bi[k] + qi * p_br[k]};
        cc[(d * 16 + h2) * 64 + p2] = (f32x2){p_cr[k], p_ci[k]};
    }
    __syncthreads();
#pragma unroll
    for (int it = 0; it < NI; ++it) {
        LAS f32x2* apow = (LAS f32x2*)(lds + it * ISZ); LAS f32x2* bbar = (LAS f32x2*)(lds + it * ISZ + 17408); LAS f32x2* cc = (LAS f32x2*)(lds + it * ISZ + 17408 + 16384); LAS float* Kt = (LAS float*)(lds + it * ISZ + 17408 + 32768);
        const int part = (it ? gp1 : gp0) & 7;
        const int pq = tid & 7, combo = tid >> 3, d = combo >> 5, hpl = (combo >> 4) & 1, h = combo & 15, hp = 2 * part + hpl; float kk[16];
#pragma unroll
        for (int m = 0; m < 16; ++m) kk[m] = 0.f;
#pragma unroll
        for (int pi = 0; pi < 8; ++pi) { const int p = pq * 8 + pi; const f32x2 c = cc[(d * 16 + hp) * 64 + p], b = bbar[(d * 64 + p) * 16 + h], a = apow[(d * 17 + 1) * 64 + p];
            float zr = c.x * b.x - c.y * b.y, zi = c.x * b.y + c.y * b.x;
#pragma unroll
            for (int m = 0; m < 16; ++m) { kk[m] += zr; const float nr = zr * a.x - zi * a.y; zi = zr * a.y + zi * a.x; zr = nr; } }
#pragma unroll
        for (int m = 0; m < 16; ++m) { float v = kk[m]; v += __shfl_xor(v, 1); v += __shfl_xor(v, 2); v += __shfl_xor(v, 4); if (pq == 0) Kt[((d * 16 + m) * 2 + hpl) * 16 + h] = v; }
    }
    __syncthreads();
#pragma unroll
    for (int k = 0; k < 4 * NI; ++k) { const int it = k >> 2, e = tid + (k & 3) * NTHR, gp = it ? gp1 : gp0, g = gp >> 3, part = gp & 7;
        LAS f32x2* apow = (LAS f32x2*)(lds + it * ISZ); LAS f32x2* cc = (LAS f32x2*)(lds + it * ISZ + 17408 + 16384); LAS float* Kt = (LAS float*)(lds + it * ISZ + 17408 + 32768);
        bf16_t* W5 = (bf16_t*)(ws + WS_WS5) + (size_t)g * 131072;
        const int rl = e >> 6, i = rl >> 1, hpl = rl & 1, hp = 2 * part + hpl, r = i * 16 + hp, c8 = (e & 63) * 8; float v[8];
        if (c8 < 256) { const int j = c8 >> 4, h0 = c8 & 15;
#pragma unroll
            for (int q = 0; q < 8; ++q) { const int h = h0 + q; float x;
                if (j < i) x = Kt[((0 * 16 + (i - j)) * 2 + hpl) * 16 + h]; else if (j > i) x = Kt[((1 * 16 + (j - i)) * 2 + hpl) * 16 + h];
                else { x = Kt[((0 * 16 + 0) * 2 + hpl) * 16 + h] + Kt[((1 * 16 + 0) * 2 + hpl) * 16 + h]; if (h == hp) x += it ? (hpl ? dsk11 : dsk10) : (hpl ? dsk01 : dsk00); }
                v[q] = x; }
        } else { const int s = c8 - 256, d = s >> 7, pt = (s >> 6) & 1, p0 = s & 63, m = d ? 16 - i : i + 1;
#pragma unroll
            for (int q = 0; q < 8; ++q) { const f32x2 c = cc[(d * 16 + hp) * 64 + p0 + q], a = apow[(d * 17 + m) * 64 + p0 + q];
                v[q] = pt ? -(c.x * a.y + c.y * a.x) : (c.x * a.x - c.y * a.y); }
        }
        u32x4 o; o.x = cvt_pk_bf16(v[0], v[1]); o.y = cvt_pk_bf16(v[2], v[3]); o.z = cvt_pk_bf16(v[4], v[5]); o.w = cvt_pk_bf16(v[6], v[7]);
        *(u32x4*)(W5 + (size_t)r * 512 + c8) = o;
    }
#pragma unroll
    for (int k = 0; k < 2 * NI; ++k) { const int it = k >> 1, e = tid + (k & 1) * NTHR, gp = it ? gp1 : gp0, g = gp >> 3, part = gp & 7;
        LAS f32x2* apow = (LAS f32x2*)(lds + it * ISZ); LAS f32x2* bbar = (LAS f32x2*)(lds + it * ISZ + 17408);
        bf16_t* MBt = (bf16_t*)(ws + WS_MB) + (size_t)g * 65536;
        const int s = part * 32 + (e >> 5), c8 = (e & 31) * 8, d = s >> 7, pt = (s >> 6) & 1, p = s & 63, j = c8 >> 4, h0 = c8 & 15, m = d ? j : 15 - j; float v[8];
        const f32x2 a = apow[(d * 17 + m) * 64 + p];
#pragma unroll
        for (int q = 0; q < 8; ++q) { const f32x2 b = bbar[(d * 64 + p) * 16 + h0 + q]; v[q] = pt ? (a.x * b.y + a.y * b.x) : (a.x * b.x - a.y * b.y); }
        u32x4 o; o.x = cvt_pk_bf16(v[0], v[1]); o.y = cvt_pk_bf16(v[2], v[3]); o.z = cvt_pk_bf16(v[4], v[5]); o.w = cvt_pk_bf16(v[6], v[7]);
        *(u32x4*)(MBt + (size_t)s * 256 + c8) = o;
    }
    __syncthreads();
}

__device__ __forceinline__ void p0_prologue(const In& in, unsigned char* ws, LAS unsigned char* lds, int G) {
    const int tid = threadIdx.x, lane = tid & 63, wave = __builtin_amdgcn_readfirstlane(tid >> 6);
    const int bx = blockIdx.x;
    const bool split = (G % 16) == 0;
    const bool roleA = split ? ((bx >> 3) & 1) != 0 : true, roleB = split ? !roleA : true;
    const int nR = split ? G / 2 : G, ir = split ? ((bx >> 4) * 8 + (bx & 7)) : bx;
    if (roleA) {
        for (int gp = ir; gp < NG * 8; gp += 2 * nR) { if (gp + nR < NG * 8) s5_tables<2>(in, ws, lds, gp, gp + nR); else s5_tables<1>(in, ws, lds, gp, gp); }
        const int gt = ir * NTHR + tid, NGT = nR * NTHR;
        LAS f32x2* trig = (LAS f32x2*)lds;
        if (tid < 128) { const float ang = (float)tid * (1.0f / 64.0f); trig[tid] = (f32x2){cospif(ang), sinpif(ang)}; }
        __syncthreads();
        for (int e = gt; e < 256 * 4 * 32; e += NGT) {
            const int c4 = e & 255, g4 = (e >> 8) & 3, c0 = (e >> 10) * 4;
            f32x4 ac[4], as[4];
#pragma unroll
            for (int q = 0; q < 4; ++q) { ac[q] = (f32x4){0.f, 0.f, 0.f, 0.f}; as[q] = (f32x4){0.f, 0.f, 0.f, 0.f}; }
            for (int j0 = 0; j0 < 128; j0 += 16) { f32x4 w[16];
#pragma unroll
                for (int jj = 0; jj < 16; ++jj) w[jj] = *(const f32x4*)(in.w_fnet + (size_t)(g4 * 128 + j0 + jj) * 1024 + 4 * c4);
#pragma unroll
                for (int jj = 0; jj < 16; ++jj) {
#pragma unroll
                    for (int q = 0; q < 4; ++q) { const f32x2 cs = trig[((j0 + jj) * (c0 + q)) & 127]; ac[q] += cs.x * w[jj]; as[q] += cs.y * w[jj]; } } }
            const float s = 1.0f / 512.0f;
#pragma unroll
            for (int k = 0; k < 4; ++k) { u32x2 oc, os;
                oc.x = cvt_pk_bf16(ac[0][k] * s, ac[1][k] * s); oc.y = cvt_pk_bf16(ac[2][k] * s, ac[3][k] * s);
                os.x = cvt_pk_bf16(as[0][k] * s, as[1][k] * s); os.y = cvt_pk_bf16(as[2][k] * s, as[3][k] * s);
                *(u32x2*)((bf16_t*)(ws + WS_WC) + (size_t)(4 * c4 + k) * 512 + g4 * 128 + c0) = oc;
                *(u32x2*)((bf16_t*)(ws + WS_WSN) + (size_t)(4 * c4 + k) * 512 + g4 * 128 + c0) = os; }
        }
        __syncthreads();
        LAS float* ctab = (LAS float*)(lds + 4096);
        for (int i = tid; i < 2048; i += NTHR) ctab[i] = cospif((float)i * (1.0f / 1024.0f));
        __syncthreads();
        for (int e = gt; e < 2 * 1024 * 128; e += NGT) {
            const int which = e >> 17, k = (e >> 7) & 1023, n0 = (e & 127) * 8, sh = which ? 1536 : 0; float v[8];
#pragma unroll
            for (int q = 0; q < 8; ++q) v[q] = ctab[(k * (n0 + q) + sh) & 2047];
            u32x4 o; o.x = cvt_pk_bf16(v[0], v[1]); o.y = cvt_pk_bf16(v[2], v[3]); o.z = cvt_pk_bf16(v[4], v[5]); o.w = cvt_pk_bf16(v[6], v[7]);
            *(u32x4*)((bf16_t*)(ws + WS_DM) + (size_t)which * 1024 * 1024 + (size_t)k * 1024 + n0) = o;
        }
        __syncthreads();
    }
    if (roleB) {
        const int gw = ir * NWAVES + wave, NGW = nR * NWAVES;
        const int gt = ir * NTHR + tid, NGT = nR * NTHR;
        {
            LAS float* scr = (LAS float*)(lds + wave * 8448);
            constexpr int I_IN = (1024 / 64) * (3072 / 32), I_PLE = (256 / 64) * (1024 / 32), I_GLU = (512 / 64) * (2048 / 32), I_OUT = (1024 / 64) * (1024 / 32), I_UP = (1024 / 64) * (4096 / 32), I_DOWN = (4096 / 64) * (1024 / 32), I_G = I_OUT;
            constexpr int NITEMS = I_IN + I_PLE + I_GLU + I_OUT + I_UP + I_DOWN + I_G;
            for (int it = gw; it < NITEMS; it += NGW) {
                int r = it;
                if (r < I_IN) { transpose_item(in.w_in, 1024, 3072, (bf16_t*)(ws + WS_WIN), in.g_mix, 0, scr, r, lane); continue; } r -= I_IN;
                if (r < I_PLE) { transpose_item(in.w_ple, 256, 1024, (bf16_t*)(ws + WS_WPLE), nullptr, 0, scr, r, lane); continue; } r -= I_PLE;
                if (r < I_GLU) { transpose_item(in.w_glu, 512, 2048, (bf16_t*)(ws + WS_WGLU), nullptr, 1, scr, r, lane); continue; } r -= I_GLU;
                if (r < I_OUT) { transpose_item(in.w_out, 1024, 1024, (bf16_t*)(ws + WS_WOUT), nullptr, 0, scr, r, lane); continue; } r -= I_OUT;
                if (r < I_UP) { transpose_item(in.w_up, 1024, 4096, (bf16_t*)(ws + WS_WUP), in.g_ffn, 0, scr, r, lane); continue; } r -= I_UP;
                if (r < I_DOWN) { transpose_item(in.w_down, 4096, 1024, (bf16_t*)(ws + WS_WDOWN), nullptr, 0, scr, r, lane); continue; } r -= I_DOWN;
                transpose_item(in.w_ple_gate, 1024, 1024, (bf16_t*)(ws + WS_WG), in.g_ple, 0, scr, r, lane);
            }
        }
        for (int c0 = gw * 4; c0 < T * DPLE / 1024; c0 += NGW * 4) {
            f32x4 v[4][4];
#pragma unroll
            for (int r = 0; r < 4; ++r) { const f32x4* pr = (const f32x4*)in.p + (size_t)(c0 + r) * 256 + lane;
#pragma unroll
                for (int j = 0; j < 4; ++j) v[r][j] = __builtin_nontemporal_load(pr + 64 * j); }
#pragma unroll
            for (int r = 0; r < 4; ++r) { u32x2* o = (u32x2*)(ws + WS_PB) + (size_t)(c0 + r) * 256 + lane;
#pragma unroll
                for (int j = 0; j < 4; ++j) o[64 * j] = pack4(v[r][j]); }
        }
        for (int m0 = gw * 4; m0 < T; m0 += NGW * 4) {
            f32x4 v[4][4]; float s[4];
#pragma unroll
            for (int r = 0; r < 4; ++r) { const f32x4* xr = (const f32x4*)(in.x + (size_t)(m0 + r) * D) + lane;
#pragma unroll
                for (int j = 0; j < 4; ++j) v[r][j] = __builtin_nontemporal_load(xr + 64 * j); }
#pragma unroll
            for (int r = 0; r < 4; ++r) { s[r] = 0.f;
#pragma unroll
                for (int j = 0; j < 4; ++j) s[r] += (v[r][j][0] * v[r][j][0] + v[r][j][1] * v[r][j][1]) + (v[r][j][2] * v[r][j][2] + v[r][j][3] * v[r][j][3]); }
#pragma unroll
            for (int r = 0; r < 4; ++r) { const float rms = sqrtf(wave_sum(s[r]) * (1.0f / D) + EPS), rstd = 1.0f / rms;
                if (lane == 0) ((float*)(ws + WS_INVR))[m0 + r] = rms;
                u32x2* o = (u32x2*)((bf16_t*)(ws + WS_XN) + (size_t)(m0 + r) * D) + lane;
#pragma unroll
                for (int j = 0; j < 4; ++j) o[64 * j] = pack4(v[r][j] * rstd); }
        }
    }
}

template <int KIND>
__device__ __forceinline__ void rstd_table(LAS unsigned char* lds, unsigned char* ws, int G, size_t ssp_off) {
    LAS float* rs = (LAS float*)(lds + RS_OFF); LAS int* r0s = (LAS int*)(lds + RS_OFF + 8192);
    Seg<KIND> S; S.ws = ws; S.G = G; S.c = blockIdx.x; S.only = -1;
    const int tid = threadIdx.x;
    if (tid < 8) { Unit u; r0s[tid] = S.next(tid, u) ? u.r0 : -1; }
    __syncthreads();
    for (int e = tid; e < 8 * 256; e += NTHR) { const int r0 = r0s[e >> 8]; if (r0 < 0) continue;
        const f32x4* p = (const f32x4*)((const float*)(ws + ssp_off) + (size_t)(r0 + (e & 255)) * 16);
        const f32x4 a = p[0], b = p[1], c = p[2], d = p[3];
        const float s = ((a[0] + a[1]) + (a[2] + a[3])) + ((b[0] + b[1]) + (b[2] + b[3])) + ((c[0] + c[1]) + (c[2] + c[3])) + ((d[0] + d[1]) + (d[2] + d[3]));
        rs[e] = 1.0f / sqrtf(s * (1.0f / D) + EPS); }
    __syncthreads();
}

struct Args { const float* in[22]; float* out; unsigned char* ws; int ph_lo, ph_hi, coop, pad; };
constexpr int N_PHASES = 9;

__global__ void __launch_bounds__(NTHR, 2) fwd_kernel(Args args) {
    extern __shared__ __attribute__((aligned(16))) unsigned char lds_raw[];
    LAS unsigned char* lds = (LAS unsigned char*)lds_raw;
    unsigned char* ws = args.ws;
    const int G = gridDim.x, tid = threadIdx.x, lane = tid & 63, wave = __builtin_amdgcn_readfirstlane(tid >> 6);
    In in; { const float* const* q = args.in; in.x = q[0]; in.p = q[1]; in.g_mix = q[2]; in.w_in = q[3]; in.lam_re = q[4]; in.lam_im = q[5]; in.log_dt = q[6]; in.b_re = q[7]; in.b_im = q[8]; in.c_re = q[9]; in.c_im = q[10];
        in.d_skip = q[11]; in.w_glu = q[12]; in.w_fnet = q[13]; in.w_out = q[14]; in.g_ffn = q[15]; in.w_up = q[16]; in.w_down = q[17]; in.g_ple = q[18]; in.w_ple_gate = q[19]; in.w_ple = q[20]; in.g_final = q[21]; }
    const int lo = args.ph_lo, hi = args.ph_hi;
#define IN_PH(k) (lo <= (k) && (k) < hi)
    if (args.coop == 2) cg::this_grid().sync();
    { volatile LAS unsigned* misc = (volatile LAS unsigned*)(lds + MISC_OFF); if (tid < 16) misc[tid] = 0u; }
    __syncthreads();
    XcdBarrier bar; bar.bar = (unsigned*)(ws + WS_CTL) + CW_BAR; bar.x = 0; bar.st = (volatile LAS unsigned*)(lds + MISC_OFF);
    if (args.coop) bar = xcd_barrier_post((unsigned*)(ws + WS_CTL) + CW_BAR, (volatile LAS unsigned*)(lds + MISC_OFF));
    const bool use_team = (G == 256) && args.coop;
    TeamBar tbar; { const int x_ = blockIdx.x & 7, k_ = blockIdx.x >> 3; tbar.cnt = (unsigned*)(ws + WS_CTL) + CW_TEAMC + (x_ * 8 + (k_ & 7)) * 64; tbar.target = 0u; tbar.same = false;
        if (use_team && tid == 0) ((unsigned*)(ws + WS_CTL))[CW_TEAMX + (x_ * 8 + (k_ & 7)) * 4 + (k_ >> 3)] = 0x100u | xb_xcc_id(); }
#define SEAM(k) do { if (IN_PH(k) && IN_PH((k) + 1)) { if (use_team && ((k) == 5 || (k) == 6 || (k) == 7)) team_barrier(tbar); else xcd_barrier(bar);     \
        if ((k) == 3 && use_team) { const unsigned* tx_ = (const unsigned*)(ws + WS_CTL) + CW_TEAMX + ((blockIdx.x & 7) * 8 + ((blockIdx.x >> 3) & 7)) * 4; \
            const unsigned a_ = xb_ld((unsigned*)tx_), b_ = xb_ld((unsigned*)tx_ + 1), c_ = xb_ld((unsigned*)tx_ + 2), d_ = xb_ld((unsigned*)tx_ + 3); tbar.same = (a_ >= 0x100u) && a_ == b_ && a_ == c_ && a_ == d_; } } } while (0)

#define PHASE_BODY_0 { p0_prologue(in, ws, lds, G); __syncthreads(); }
    if (IN_PH(0)) { PHASE_BODY_0 if ((PROBE_DUP >> 0) & 1) { PHASE_BODY_0 } }
    SEAM(0);
#define PHASE_BODY_1 { \
        { EpiP1Main E; E.ws = ws; run_segment<SG_P1MAIN>(lds, ws, G, E); } \
        { EpiP1Swap E; E.ws = ws; run_segment<SG_P1SWAP>(lds, ws, G, E); } \
        { EpiStore E; E.O = (bf16_t*)(ws + WS_PP); E.ldo = 1024; run_segment<SG_P1PP>(lds, ws, G, E); } \
    }
    if (IN_PH(1)) { PHASE_BODY_1 if ((PROBE_DUP >> 1) & 1) { PHASE_BODY_1 } }
    SEAM(1);
#define PHASE_BODY_2 { \
        { EpiScan E; E.ws = ws; E.ebuf = (LAS float*)lds; run_segment<SG_E>(lds, ws, G, E); } \
        { EpiDft E; E.ws = ws; run_segment<SG_DFT>(lds, ws, G, E); } \
        for (int o = (blockIdx.x * NWAVES + wave); o < NB * 512; o += G * NWAVES) {        \
            const bf16_t* er = (const bf16_t*)(ws + WS_UT) + (size_t)o * 1024 + lane * 16; \
            const u32x4 w0 = *(const u32x4*)er, w1 = *(const u32x4*)(er + 8); \
            const f32x4 x0 = unpack_lo(w0), x1 = unpack_hi(w0), x2 = unpack_lo(w1), x3 = unpack_hi(w1); \
            float s = ((x0[0] - x0[1]) + (x0[2] - x0[3])) + ((x1[0] - x1[1]) + (x1[2] - x1[3])) + ((x2[0] - x2[1]) + (x2[2] - x2[3])) + ((x3[0] - x3[1]) + (x3[2] - x3[3])); \
            s = wave_sum(s) + ((const float*)(ws + WS_U1024))[o]; \
            if (lane == 0) ((bf16_t*)(ws + WS_R))[((size_t)(o >> 9) * 2048 + 1024) * 512 + (o & 511)] = (bf16_t)(cvt_pk_bf16(s, 0.f) & 0xffffu); \
        } \
    }
    if (IN_PH(2)) { PHASE_BODY_2 if ((PROBE_DUP >> 2) & 1) { PHASE_BODY_2 } }
    SEAM(2);
#define PHASE_BODY_3 { \
        { EpiP3All E; E.ws = ws; E.Y = (bf16_t*)args.out; run_segment<SG_P3ALL>(lds, ws, G, E); } \
        \
        for (int e = blockIdx.x * NTHR + tid; e < NB * 1024 * 8; e += G * NTHR) { \
            const int part = e & 7, o = e >> 3, b = o >> 10, col = o & 1023; \
            const bf16_t* r = (const bf16_t*)(ws + WS_R) + ((size_t)b * 2048 + 1024) * 512 + part * 64; \
            const bf16_t* w = (const bf16_t*)(ws + WS_WC) + (size_t)col * 512 + part * 64; float s = 0.f; \
_Pragma("unroll") \
            for (int q = 0; q < 16; ++q) { const f32x4 a = unpack4(*(const u32x2*)(r + 4 * q)), c = unpack4(*(const u32x2*)(w + 4 * q)); s += (a[0] * c[0] + a[1] * c[1]) + (a[2] * c[2] + a[3] * c[3]); } \
            s += __shfl_xor(s, 1); s += __shfl_xor(s, 2); s += __shfl_xor(s, 4); \
            if (part == 0) ((bf16_t*)args.out)[((size_t)b * 2048 + 1024) * 1024 + col] = (bf16_t)(cvt_pk_bf16(s, 0.f) & 0xffffu); \
        } \
    }
    if (IN_PH(3)) { PHASE_BODY_3 if ((PROBE_DUP >> 3) & 1) { PHASE_BODY_3 } }
    SEAM(3);
#define PHASE_BODY_4 { EpiGluM E; E.ws = ws; E.Y = (const bf16_t*)args.out; run_segment<SG_GLU>(lds, ws, G, E); }
    if (IN_PH(4)) { PHASE_BODY_4 if ((PROBE_DUP >> 4) & 1) { PHASE_BODY_4 } }
    SEAM(4);
#define PHASE_BODY_5 { EpiRes<0> E; E.x = in.x; E.ws = ws; E.ss = 0.f; run_segment<SG_OUT>(lds, ws, G, E); }
    if (IN_PH(5)) { PHASE_BODY_5 if ((PROBE_DUP >> 5) & 1) { PHASE_BODY_5 } }
    SEAM(5);
#define PHASE_BODY_6 { EpiUp E; E.ws = ws; E.rs = (const LAS float*)(lds + RS_OFF); E.hlo = (bf16_t*)args.out; run_segment<SG_UP>(lds, ws, G, E, [&]() { rstd_table<SG_UP>(lds, ws, G, WS_SSP1); }); }
    if (IN_PH(6)) { PHASE_BODY_6 if ((PROBE_DUP >> 6) & 1) { PHASE_BODY_6 } }
    SEAM(6);
    if (IN_PH(7)) { EpiRes<1> E; E.x = nullptr; E.ws = ws; E.ss = 0.f; run_segment<SG_DOWN>(lds, ws, G, E, NoHook(), (const void*)args.out); }
    SEAM(7);
    if (IN_PH(8)) { EpiFinal E; E.ws = ws; E.out = args.out; E.rs = (const LAS float*)(lds + RS_OFF); E.gfin = in.g_final; run_segment<SG_GATE>(lds, ws, G, E, [&]() { rstd_table<SG_GATE>(lds, ws, G, WS_SSP2); }); }
#undef IN_PH
#undef SEAM
}


#if DBG_STOP >= 0
__device__ __forceinline__ float bf2f(bf16_t v) { return __uint_as_float(((unsigned)v) << 16); }
__global__ void dbg_dump(float* dst, const float* out, const unsigned char* ws, int k) {
    const size_t n = (size_t)T * D;
    for (size_t i = (size_t)blockIdx.x * blockDim.x + threadIdx.x; i < n; i += (size_t)gridDim.x * blockDim.x) {
        float v = 0.f;
        if (k == 0) { v = bf2f(((const bf16_t*)(ws + WS_XN))[i]) + 2.f * bf2f(((const bf16_t*)(ws + WS_WIN))[i % (3072 * 1024)]) + 3.f * bf2f(((const bf16_t*)(ws + WS_WS5))[i % (32 * 256 * 512)]) + 5.f * bf2f(((const bf16_t*)(ws + WS_MB))[i % (32 * 65536)])
                    + 7.f * bf2f(((const bf16_t*)(ws + WS_DM))[i % (2048 * 2048)]) + 11.f * bf2f(((const bf16_t*)(ws + WS_WC))[i % (1024 * 512)]) + 13.f * bf2f(((const bf16_t*)(ws + WS_WSN))[i % (1024 * 512)]) + 0.5f * bf2f(((const bf16_t*)(ws + WS_PB))[i % ((size_t)T * 256)])
                    + bf2f(((const bf16_t*)(ws + WS_WGLU))[i % (2048 * 512)]) + bf2f(((const bf16_t*)(ws + WS_WUP))[i % (4096 * 1024)]) + bf2f(((const bf16_t*)(ws + WS_WDOWN))[i % (4096 * 1024)]) + bf2f(((const bf16_t*)(ws + WS_WG))[i % (1024 * 1024)]) + bf2f(((const bf16_t*)(ws + WS_WOUT))[i % (1024 * 1024)]) + bf2f(((const bf16_t*)(ws + WS_WPLE))[i % (1024 * 256)]) + ((const float*)(ws + WS_AL))[i % 8192]; }
        if (k == 1) { v = bf2f(((const bf16_t*)(ws + WS_ZA))[i]) + 2.f * bf2f(((const bf16_t*)(ws + WS_ZB))[i]) + 3.f * bf2f(((const bf16_t*)(ws + WS_PP))[i]) + 5.f * bf2f(((const bf16_t*)(ws + WS_XS))[(i & ~511ull) + (i & 255)]) + 7.f * bf2f(((const bf16_t*)(ws + WS_UT))[i % ((size_t)T * 512)]); }
        if (k == 2) { v = bf2f(((const bf16_t*)(ws + WS_XS))[i]) + 3.f * bf2f(((const bf16_t*)(ws + WS_R))[i % ((size_t)T * 512)]); }
        if (k == 3) { v = bf2f(((const bf16_t*)out)[i]) + 3.f * bf2f(((const bf16_t*)(ws + WS_YS))[i % ((size_t)T * 512)]); }
        if (k == 4) { v = bf2f(((const bf16_t*)(ws + WS_MG))[i]); }
        dst[i] = v;
    }
}
#endif
extern "C" void kernel_launch(void* const* d_in, const int* in_sizes, int n_in, void* d_out, int out_size, void* d_ws, size_t ws_size, hipStream_t stream) {
    static int grid = 0;
    if (grid == 0) {
        if (n_in != 22 || in_sizes[0] != T * D || out_size != T * D || ws_size < WS_END) { fprintf(stderr, "kernel_launch: unexpected problem (n_in %d, in0 %d, out %d, ws %zu < %zu)\n", n_in, n_in > 0 ? in_sizes[0] : -1, out_size, ws_size, (size_t)WS_END); grid = -1; return; }
        int dev = 0, cus = 0, per_cu = 0;
        if (hipGetDevice(&dev) != hipSuccess || hipDeviceGetAttribute(&cus, hipDeviceAttributeMultiprocessorCount, dev) != hipSuccess) { grid = -1; return; }
        if (hipFuncSetAttribute((const void*)fwd_kernel, hipFuncAttributeMaxDynamicSharedMemorySize, LDS_BYTES) != hipSuccess) { fprintf(stderr, "kernel_launch: hipFuncSetAttribute failed\n"); grid = -1; return; }
        if (hipOccupancyMaxActiveBlocksPerMultiprocessor(&per_cu, (const void*)fwd_kernel, NTHR, LDS_BYTES) != hipSuccess || per_cu < 1) { fprintf(stderr, "kernel_launch: occupancy query says %d blocks per CU\n", per_cu); (void)hipGetLastError(); per_cu = 1; }
        grid = cus * (per_cu < 1 ? 1 : 1);
    }
    if (grid < 0) return;
    (void)hipMemsetAsync((char*)d_ws + WS_CTL, 0, CTL_BYTES, stream);
    Args a{};
    for (int i = 0; i < 22; ++i) a.in[i] = (const float*)d_in[i];
    a.out = (float*)d_out; a.ws = (unsigned char*)d_ws;
#if N_LAUNCH_MODE
#if DBG_STOP >= 0
    for (int ph = 0; ph <= DBG_STOP; ++ph) { a.ph_lo = ph; a.ph_hi = ph + 1; a.coop = 0; hipLaunchKernelGGL(fwd_kernel, dim3(grid), dim3(NTHR), LDS_BYTES, stream, a); }
    if (DBG_STOP == 3) { hipLaunchKernelGGL(dbg_dump, dim3(2048), dim3(256), 0, stream, (float*)((char*)d_ws + WS_PP), (const float*)d_out, (const unsigned char*)d_ws, (int)DBG_STOP);
        (void)hipMemcpyAsync(d_out, (char*)d_ws + WS_PP, (size_t)T * D * 4, hipMemcpyDeviceToDevice, stream); }
    else if (DBG_STOP <= 4) hipLaunchKernelGGL(dbg_dump, dim3(2048), dim3(256), 0, stream, (float*)d_out, (const float*)d_out, (const unsigned char*)d_ws, (int)DBG_STOP);
#else
    for (int ph = 0; ph < N_PHASES; ++ph) { a.ph_lo = ph; a.ph_hi = ph + 1; a.coop = 0; hipLaunchKernelGGL(fwd_kernel, dim3(grid), dim3(NTHR), LDS_BYTES, stream, a); }
#endif
#else
    a.ph_lo = 0; a.ph_hi = N_PHASES; a.coop = 1;
    void* kargs[] = {&a};
    hipError_t e = hipLaunchCooperativeKernel((const void*)fwd_kernel, dim3(grid), dim3(NTHR), kargs, LDS_BYTES, stream);
    if (e != hipSuccess) fprintf(stderr, "kernel_launch: cooperative launch failed: %s (grid %d)\n", hipGetErrorString(e), grid);
#endif
}
```

```cpp
#include <hip/hip_runtime.h>
#include <hip/hip_cooperative_groups.h>
#include <cstdio>
#include <cstdint>
#include <type_traits>
namespace cg = cooperative_groups;

#ifndef FAST_MASK
#define FAST_MASK 0x3FFF
#endif
#ifndef N_LAUNCH_MODE
#define N_LAUNCH_MODE 0
#endif

#ifndef PROBE_DUP
#define PROBE_DUP 0
#endif
#ifndef DBG_STOP
#define DBG_STOP -1
#endif
#define LAS __attribute__((address_space(3)))
typedef unsigned short bf16_t;
typedef short bf16x8 __attribute__((ext_vector_type(8)));
typedef float f32x4 __attribute__((ext_vector_type(4)));
typedef float f32x2 __attribute__((ext_vector_type(2)));
typedef unsigned u32x2 __attribute__((ext_vector_type(2)));
typedef unsigned u32x4 __attribute__((ext_vector_type(4)));

constexpr int T = 32768, D = 1024, SEQ = 2048, NB = 16, DFF = 4096, DPLE = 256;
constexpr int NG = 32;
constexpr float EPS = 1e-6f;
constexpr int NWAVES = 8, NTHR = 512;

constexpr size_t MiB = 1u << 20;
constexpr size_t WS_CTL = 0, CTL_BYTES = 1 * MiB;
constexpr size_t CTL_SS3 = 256 * 1024;
constexpr size_t CTL_CNT = 512 * 1024;
constexpr size_t WS_WIN = 1 * MiB;
constexpr size_t WS_WPLE = 7 * MiB;
constexpr size_t WS_MB = 8 * MiB;
constexpr size_t WS_WS5 = 12 * MiB;
constexpr size_t WS_DM = 20 * MiB;
constexpr size_t WS_WC = 28 * MiB;
constexpr size_t WS_WSN = 29 * MiB;
constexpr size_t WS_WGLU = 30 * MiB;
constexpr size_t WS_WOUT = 32 * MiB;
constexpr size_t WS_WUP = 34 * MiB;
constexpr size_t WS_WDOWN = 42 * MiB;
constexpr size_t WS_WG = 50 * MiB;
constexpr size_t WS_AL = 52 * MiB;
constexpr size_t WS_U1024 = 52 * MiB + 65536;
constexpr size_t WS_INVR = 52 * MiB + 131072;
constexpr size_t WS_SSP1 = 53 * MiB;
constexpr size_t WS_SSP2 = 55 * MiB;
constexpr size_t WS_PP = 60 * MiB;
constexpr size_t WS_XB = 124 * MiB;
constexpr size_t WS_Z = 188 * MiB;
constexpr size_t WS_XN = WS_Z;
constexpr size_t WS_XS = WS_Z + 64 * MiB;
constexpr size_t WS_UT = WS_Z + 128 * MiB;
constexpr size_t WS_ZA = WS_Z + 160 * MiB;
constexpr size_t WS_ZB = WS_Z + 224 * MiB;
constexpr size_t WS_PB = WS_Z + 192 * MiB;
constexpr size_t WS_R = WS_Z + 288 * MiB;
constexpr size_t WS_YS = WS_Z + 128 * MiB;
constexpr size_t WS_MG = WS_Z + 64 * MiB;
constexpr size_t WS_HHI = WS_Z + 128 * MiB;
constexpr size_t WS_END = WS_Z + 320 * MiB;

constexpr int RING_BYTES = 131072;
constexpr int RS_OFF = 135168;
constexpr int MISC_OFF = 143616;
constexpr int LDS_BYTES = 147456;

typedef __bf16 bf16x2_t __attribute__((ext_vector_type(2)));
__device__ __forceinline__ unsigned cvt_pk_bf16(float lo, float hi) { const f32x2 v = {lo, hi}; const bf16x2_t r = __builtin_convertvector(v, bf16x2_t); return __builtin_bit_cast(unsigned, r); }
__device__ __forceinline__ u32x2 pack4(f32x4 v) { u32x2 w; w.x = cvt_pk_bf16(v[0], v[1]); w.y = cvt_pk_bf16(v[2], v[3]); return w; }
__device__ __forceinline__ f32x4 unpack4(u32x2 w) { f32x4 v; v[0] = __uint_as_float(w.x << 16); v[1] = __uint_as_float(w.x & 0xffff0000u); v[2] = __uint_as_float(w.y << 16); v[3] = __uint_as_float(w.y & 0xffff0000u); return v; }
__device__ __forceinline__ u32x4 pack8(f32x4 lo, f32x4 hi) { u32x4 w; w.x = cvt_pk_bf16(lo[0], lo[1]); w.y = cvt_pk_bf16(lo[2], lo[3]); w.z = cvt_pk_bf16(hi[0], hi[1]); w.w = cvt_pk_bf16(hi[2], hi[3]); return w; }
__device__ __forceinline__ f32x4 unpack_lo(u32x4 w) { u32x2 t; t.x = w.x; t.y = w.y; return unpack4(t); }
__device__ __forceinline__ f32x4 unpack_hi(u32x4 w) { u32x2 t; t.x = w.z; t.y = w.w; return unpack4(t); }
__device__ __forceinline__ unsigned q8x4(f32x4 s) {
    return (unsigned)(s[0] * 255.f + 0.5f) | ((unsigned)(s[1] * 255.f + 0.5f) << 8) | ((unsigned)(s[2] * 255.f + 0.5f) << 16) | ((unsigned)(s[3] * 255.f + 0.5f) << 24); }
__device__ __forceinline__ f32x4 dq8x4(unsigned w) { f32x4 r; r[0] = (float)(w & 255u); r[1] = (float)((w >> 8) & 255u); r[2] = (float)((w >> 16) & 255u); r[3] = (float)(w >> 24); return r * (1.0f / 255.f); }
__device__ __forceinline__ float sigmoidf_(float x) { return __builtin_amdgcn_rcpf(1.0f + __builtin_amdgcn_exp2f(-1.4426950409f * x)); }
__device__ __forceinline__ f32x4 sigmoid4(f32x4 v) { f32x4 r; r[0] = sigmoidf_(v[0]); r[1] = sigmoidf_(v[1]); r[2] = sigmoidf_(v[2]); r[3] = sigmoidf_(v[3]); return r; }
__device__ __forceinline__ float gelu_tanh(float x) { return x * sigmoidf_(1.5957691216f * (x + 0.044715f * x * x * x)); }
__device__ __forceinline__ float wave_sum(float v) {
#pragma unroll
    for (int o = 1; o < 64; o <<= 1) v += __shfl_xor(v, o);
    return v;
}
#define LDS_WAIT() asm volatile("s_waitcnt lgkmcnt(0)" ::: "memory")


#define XB_TMO      128
#define XB_XCNT(j)  (256  + 64 * (j))
#define XB_XSUB(j)  (1280 + 64 * (j))
#define XB_XGEN(j)  (2304 + 64 * (j))
#define XB_TOP      3328
#define XB_TOPGEN   3392
#define XCD_BAR_WORDS 3456
#define XB_SPIN_CAP (1u << 18)
constexpr int CW_BAR = 4096;
__device__ __forceinline__ unsigned xb_ld(unsigned* p)              { return __hip_atomic_load(p, __ATOMIC_RELAXED, __HIP_MEMORY_SCOPE_AGENT); }
__device__ __forceinline__ unsigned xb_add(unsigned* p, unsigned v) { return __hip_atomic_fetch_add(p, v, __ATOMIC_RELAXED, __HIP_MEMORY_SCOPE_AGENT); }
__device__ __forceinline__ unsigned xb_xcc_id() { return (unsigned)__builtin_amdgcn_s_getreg((3 << 11) | 20) & 0xFu; }
#define XB_SPIN(cond, bar) do { unsigned _sp = 0; while (cond) { __builtin_amdgcn_s_sleep(1); \
    if ((++_sp & 255u) == 0u) { if (xb_ld(&(bar)[XB_TMO])) break; if (_sp > XB_SPIN_CAP) { atomicAdd(&(bar)[XB_TMO], 1u); break; } } } } while (0)
struct XcdBarrier { unsigned* bar; unsigned x; volatile LAS unsigned* st; };
__device__ __forceinline__ XcdBarrier xcd_barrier_post(unsigned* bar, volatile LAS unsigned* st) {
    XcdBarrier b; b.bar = bar; b.x = xb_xcc_id(); b.st = st;
    if (threadIdx.x == 0) (void)xb_add(&bar[XB_XCNT(b.x)], 1u);
    return b;
}
__device__ __forceinline__ void xcd_barrier_complete(unsigned* bar, unsigned x, unsigned& nloc, unsigned& nx) {
    const unsigned G = gridDim.x * gridDim.y * gridDim.z;
    unsigned sum, cnt, mine, sp = 0u;
    for (;;) {
        sum = 0u; cnt = 0u; mine = 0u;
#pragma unroll
        for (unsigned j = 0; j < 16; ++j) { const unsigned c = xb_ld(&bar[XB_XCNT(j)]); sum += c; cnt += (c > 0u) ? 1u : 0u; mine = (j == x) ? c : mine; }
        if (sum == G) break;
        __builtin_amdgcn_s_sleep(1);
        if ((++sp & 255u) == 0u) { if (xb_ld(&bar[XB_TMO])) break; if (sp > XB_SPIN_CAP) { atomicAdd(&bar[XB_TMO], 1u); break; } }
    }
    nloc = mine > 0u ? mine : 1u; nx = cnt > 0u ? cnt : 1u;
}
__device__ __forceinline__ void xcd_barrier(const XcdBarrier& b) {
    asm volatile("s_waitcnt vmcnt(0)" ::: "memory");
    __syncthreads();
    if (threadIdx.x == 0) {
        unsigned* bar = b.bar;
        __builtin_amdgcn_s_waitcnt(0);
        unsigned nloc = b.st[0], nx = b.st[1];
        if (nloc == 0u) { xcd_barrier_complete(bar, b.x, nloc, nx); b.st[0] = nloc; b.st[1] = nx; }
        const unsigned old = xb_add(&bar[XB_XSUB(b.x)], 1u);
        const unsigned gen = old / nloc;
        if (old + 1u == (gen + 1u) * nloc) {
            __builtin_amdgcn_fence(__ATOMIC_RELEASE, "agent");
            asm volatile("s_waitcnt vmcnt(0)" ::: "memory");
            const unsigned og = xb_add(&bar[XB_TOP], 1u);
            const unsigned tg = og / nx;
            if (og + 1u == (tg + 1u) * nx) xb_add(&bar[XB_TOPGEN], 1u);
            else XB_SPIN(xb_ld(&bar[XB_TOPGEN]) == tg, bar);
            __builtin_amdgcn_fence(__ATOMIC_ACQUIRE, "agent");
            xb_add(&bar[XB_XGEN(b.x)], 1u);
            asm volatile("s_waitcnt vmcnt(0)" ::: "memory");
        } else {
            XB_SPIN(xb_ld(&bar[XB_XGEN(b.x)]) == gen, bar);
            __builtin_amdgcn_fence(__ATOMIC_ACQUIRE, "agent");
            asm volatile("s_waitcnt vmcnt(0)" ::: "memory");
        }
    }
    __syncthreads();
}

constexpr int CW_TEAMX = 12288, CW_TEAMC = 16384, CW_GRPX = 24576, CW_GRPC = 28672;
struct TeamBar { unsigned* cnt; unsigned target; bool same; unsigned n; };
__device__ __forceinline__ void team_barrier(TeamBar& tb) {
    asm volatile("s_waitcnt vmcnt(0)" ::: "memory");
    __syncthreads();
    tb.target += tb.n;
    if (threadIdx.x == 0) {
        __builtin_amdgcn_s_waitcnt(0);
        if (!tb.same) { __builtin_amdgcn_fence(__ATOMIC_RELEASE, "agent"); asm volatile("s_waitcnt vmcnt(0)" ::: "memory"); }
        xb_add(tb.cnt, 1u);
        { unsigned sp = 0; while (xb_ld(tb.cnt) < tb.target) { __builtin_amdgcn_s_sleep(1); if (++sp > (1u << 22)) break; } }
        __builtin_amdgcn_fence(__ATOMIC_ACQUIRE, "agent");
        asm volatile("s_waitcnt vmcnt(0)" ::: "memory");
    }
    __syncthreads();
}

struct Unit { const bf16_t* A; const bf16_t* B; const bf16_t* A2; int r0, c0, slot, aux, sub; };
constexpr int NXCD = 8, WGM = 8;
__device__ __forceinline__ bool unit_order(int L, int nM, int nN, int& pm, int& pn) {
    const int nwg = nM * nN; if (L >= nwg) return false;
    int wgid = L; { const int q = nwg / NXCD, r = nwg % NXCD, xcd = wgid % NXCD, off = wgid / NXCD; wgid = (xcd < r ? xcd * (q + 1) : r * (q + 1) + (xcd - r) * q) + off; }
    const int nig = WGM * nN, gid = wgid / nig, fm = gid * WGM, gsz = (nM - fm) < WGM ? (nM - fm) : WGM;
    pm = fm + ((wgid % nig) % gsz); pn = (wgid % nig) / gsz; return true;
}
enum SegKind { SG_P1MAIN = 0, SG_P1SWAP, SG_P1PP, SG_E, SG_DFT, SG_Y, SG_FNET, SG_GLU, SG_OUT, SG_UP, SG_DOWN, SG_GATE, SG_P1ALL  , SG_P3ALL  , SG_N };
struct Ptrs {
    const float* x; float* out; unsigned char* ws;
};
template <int KIND> struct Seg {
    unsigned char* ws; int G, c, only;
    const void* ext = nullptr;
    static constexpr bool SPLITA = (KIND == SG_DOWN);
    __device__ __forceinline__ static constexpr int nM() { return (KIND == SG_P1SWAP) ? 2 : (KIND == SG_E || KIND == SG_Y) ? 256 : 128; }
    __device__ __forceinline__ static constexpr int nN() { return KIND == SG_P1MAIN ? 10 : KIND == SG_P1SWAP ? 128 : KIND == SG_P1PP ? 4 : (KIND == SG_E || KIND == SG_Y) ? 1 : KIND == SG_DFT ? 2 : KIND == SG_FNET ? 4 : KIND == SG_GLU ? 8 : KIND == SG_UP ? 16 : 4; }
    static constexpr bool CUSTOMB = (KIND == SG_P1SWAP);
    static constexpr bool CUSTOMA = (KIND == SG_GLU);
    __device__ __forceinline__ static constexpr int lda() { return (KIND == SG_P1PP) ? 256 : (KIND == SG_E || KIND == SG_Y || KIND == SG_FNET || KIND == SG_GLU || KIND == SG_P3ALL) ? 512 : KIND == SG_DOWN ? 2048 : 1024; }
    __device__ __forceinline__ static constexpr int ldb() { return (KIND == SG_P1PP || KIND == SG_E) ? 256 : (KIND == SG_Y || KIND == SG_FNET || KIND == SG_GLU || KIND == SG_P3ALL) ? 512 : KIND == SG_DOWN ? 4096 : 1024; }
    __device__ __forceinline__ static constexpr int K() { return (KIND == SG_P1PP || KIND == SG_E) ? 256 : (KIND == SG_Y || KIND == SG_FNET || KIND == SG_GLU || KIND == SG_P3ALL) ? 512 : KIND == SG_DOWN ? 4096 : 1024; }
    __device__ __forceinline__ static constexpr int total() { return KIND == SG_P1ALL ? 1280 + 256 : KIND == SG_P3ALL ? 256 + 512 : nM() * nN(); }
    __device__ __forceinline__ int count() const { const int n = total(); return (n - c + G - 1) / G; }
    __device__ __forceinline__ bool next(int i, Unit& u) const {
        if (only >= 0) { if (i != 0) return false; i = only; }
        u.slot = i; u.aux = 0; u.sub = 0;
        if constexpr (KIND == SG_P1ALL) {
            const int L = i * G + c; int pm, pn; if (L >= total()) return false;
            if (L < 1280) { unit_order(L, 128, 10, pm, pn); u.A = (const bf16_t*)(ws + WS_XN) + (size_t)pm * 256 * 1024; u.B = (const bf16_t*)(ws + WS_WIN) + (size_t)(pn < 2 ? pn : pn + 2) * 256 * 1024; u.r0 = pm * 256; u.c0 = pn * 256; }
            else { unit_order(L - 1280, 2, 128, pm, pn); u.sub = 1; u.A = (const bf16_t*)(ws + WS_WIN) + (size_t)(512 + pm * 256) * 1024; u.B = (const bf16_t*)(ws + WS_XN) + (size_t)pn * 256 * 1024; u.r0 = pm * 256; u.c0 = pn * 256; }
            return true;
        }
        if constexpr (KIND == SG_P3ALL) {
            const int L = i * G + c; int pm, pn; if (L >= total()) return false;
            if (L < 256) { unit_order(L, 256, 1, pm, pn); const int g = pm >> 3, rt = pm & 7; u.A = (const bf16_t*)(ws + WS_XS) + ((size_t)g * 2048 + rt * 256) * 512; u.B = (const bf16_t*)(ws + WS_WS5) + (size_t)g * 131072; u.r0 = rt * 256; u.c0 = 0; u.aux = g; }
            else { unit_order(L - 256, 128, 4, pm, pn); u.sub = 1; u.A = (const bf16_t*)(ws + WS_R) + (size_t)pm * 256 * 512; u.B = (const bf16_t*)(ws + ((pm & 7) < 4 ? WS_WC : WS_WSN)) + (size_t)pn * 256 * 512; u.r0 = pm * 256; u.c0 = pn * 256; }
            return true;
        }
        int pm, pn; if (!unit_order(i * G + c, nM(), nN(), pm, pn)) return false;
        if constexpr (KIND == SG_P1MAIN) { u.A = (const bf16_t*)(ws + WS_XN) + (size_t)pm * 256 * 1024; u.B = (const bf16_t*)(ws + WS_WIN) + (size_t)(pn < 2 ? pn : pn + 2) * 256 * 1024; u.r0 = pm * 256; u.c0 = pn * 256; }
        if constexpr (KIND == SG_P1SWAP) { u.A = (const bf16_t*)(ws + WS_WIN) + (size_t)(512 + pm * 256) * 1024; u.B = (const bf16_t*)(ws + WS_XN) + (size_t)(pn >> 3) * 2048 * 1024; u.r0 = pm * 256; u.c0 = (pn & 7) * 128; u.aux = pn >> 3; }
        if constexpr (KIND == SG_P1PP) { u.A = (const bf16_t*)(ws + WS_PB) + (size_t)pm * 256 * 256; u.B = (const bf16_t*)(ws + WS_WPLE) + (size_t)pn * 256 * 256; u.r0 = pm * 256; u.c0 = pn * 256; }
        if constexpr (KIND == SG_E) { const int g = pm & 31, rt = pm >> 5;
            u.A = (const bf16_t*)(ws + WS_XS) + ((size_t)g * 2048 + rt * 256) * 512; u.B = (const bf16_t*)(ws + WS_MB) + (size_t)g * 65536; u.r0 = rt * 256; u.c0 = 0; u.aux = g; }
        if constexpr (KIND == SG_DFT) { const int b = pm >> 3, rt = pm & 7; u.A = (const bf16_t*)(ws + WS_DM) + (size_t)rt * 256 * 1024;
            u.B = (const bf16_t*)(ws + WS_UT) + ((size_t)(rt < 4 ? 0 : 16) * 512 + (size_t)b * 512 + pn * 256) * 1024; u.r0 = pm * 256; u.c0 = pn * 256; u.aux = b; }
        if constexpr (KIND == SG_Y) { const int g = pm >> 3, rt = pm & 7; u.A = (const bf16_t*)(ws + WS_XS) + ((size_t)g * 2048 + rt * 256) * 512; u.B = (const bf16_t*)(ws + WS_WS5) + (size_t)g * 131072; u.r0 = rt * 256; u.c0 = 0; u.aux = g; }
        if constexpr (KIND == SG_FNET) { u.A = (const bf16_t*)(ws + WS_R) + (size_t)pm * 256 * 512; u.B = (const bf16_t*)(ws + ((pm & 7) < 4 ? WS_WC : WS_WSN)) + (size_t)pn * 256 * 512; u.r0 = pm * 256; u.c0 = pn * 256; }
        if constexpr (KIND == SG_GLU) { const int b = pm >> 3, jt = pm & 7;
            u.A = (const bf16_t*)(ws + WS_YS) + ((size_t)b * 2048 + jt * 128) * 512; u.A2 = (const bf16_t*)(ws + WS_YS) + ((size_t)b * 2048 + 2048 - jt * 128 - 127) * 512;
            u.B = (const bf16_t*)(ws + WS_WGLU) + (size_t)pn * 256 * 512; u.r0 = b * 2048; u.c0 = pn * 128; u.aux = jt; u.sub = (jt == 0); }
        if constexpr (KIND == SG_OUT) { u.A = (const bf16_t*)(ws + WS_MG) + (size_t)pm * 256 * 1024; u.B = (const bf16_t*)(ws + WS_WOUT) + (size_t)pn * 256 * 1024; u.r0 = pm * 256; u.c0 = pn * 256; }
        if constexpr (KIND == SG_UP) { u.A = (const bf16_t*)(ws + WS_XB) + (size_t)pm * 256 * 1024; u.B = (const bf16_t*)(ws + WS_WUP) + (size_t)pn * 256 * 1024; u.r0 = pm * 256; u.c0 = pn * 256; }
        if constexpr (KIND == SG_DOWN) { u.A = (const bf16_t*)ext + (size_t)pm * 256 * 2048; u.A2 = (const bf16_t*)(ws + WS_HHI) + (size_t)pm * 256 * 2048; u.B = (const bf16_t*)(ws + WS_WDOWN) + (size_t)pn * 256 * 4096; u.r0 = pm * 256; u.c0 = pn * 256; }
        if constexpr (KIND == SG_GATE) { u.A = (const bf16_t*)(ws + WS_XB) + (size_t)pm * 256 * 1024; u.B = (const bf16_t*)(ws + WS_WG) + (size_t)pn * 256 * 1024; u.r0 = pm * 256; u.c0 = pn * 256; }
        return true;
    }
};

struct NoPre {};
struct EpiBase {
    static constexpr bool AFTER_DRAIN = false, WHOLE_TILE = false;
    static constexpr int MB = 4;
    typedef NoPre Pre;
    __device__ __forceinline__ void load(const Unit&, int, int, NoPre&) {}
    __device__ __forceinline__ void row_begin() {}
    __device__ __forceinline__ void row_end(const Unit&, int, int, int) {}
    __device__ __forceinline__ void half_done(const Unit&, int) {}
};
struct EpiStore : EpiBase {
    bf16_t* O; int ldo;
    __device__ __forceinline__ void pair8(const Unit& u, int lrow, int colq, f32x4 a0, f32x4 a1, f32x4 b0, f32x4 b1, const Pre&) {
        bf16_t* p = O + (size_t)(u.r0 + lrow) * ldo + u.c0 + colq;
        *(u32x4*)p = pack8(a0, a1); *(u32x4*)(p + 32) = pack8(b0, b1);
    }
};
struct EpiP1Main : EpiBase {
    unsigned char* ws;
    __device__ __forceinline__ void pair8(const Unit& u, int lrow, int colq, f32x4 a0, f32x4 a1, f32x4 b0, f32x4 b1, const Pre&) {
        const int t = u.r0 + lrow;
        if (u.c0 < 512) {
            const int b = t >> 11, pos = t & 2047, c = pos >> 4, j = pos & 15;
#pragma unroll
            for (int bj = 0; bj < 2; ++bj) { const int vcol = u.c0 + colq + bj * 32, g = vcol >> 4, h = vcol & 15;
                bf16_t* p = (bf16_t*)(ws + WS_XS) + ((size_t)g * 2048 + b * 128 + c) * 512 + j * 16 + h; *(u32x4*)p = bj ? pack8(b0, b1) : pack8(a0, a1); }
        } else {
            const int zc = u.c0 - 512; unsigned char* base = ws + (zc < 1024 ? WS_ZA : WS_ZB) + (size_t)t * 1024 + (zc & 1023) + colq;
            u32x2 wa, wb; wa.x = q8x4(sigmoid4(a0)); wa.y = q8x4(sigmoid4(a1)); wb.x = q8x4(sigmoid4(b0)); wb.y = q8x4(sigmoid4(b1));
            *(u32x2*)base = wa; *(u32x2*)(base + 32) = wb;
        }
    }
};
struct EpiP1Swap : EpiBase {
    unsigned char* ws;
    __device__ __forceinline__ void pair8(const Unit& u, int lrow, int colq, f32x4 a0, f32x4 a1, f32x4 b0, f32x4 b1, const Pre&) {
        const int ch = u.r0 + lrow, n0 = u.c0 + (colq >> 6) * 32 + (colq & 63);
        f32x4 e0 = a0 + b0, e1 = a1 + b1, o0 = a0 - b0, o1 = a1 - b1;
        if (n0 == 0) { e0[0] = a0[0]; o0[0] = 0.f; ((float*)(ws + WS_U1024))[u.aux * 512 + ch] = b0[0]; }
        const size_t off = ((size_t)u.aux * 512 + ch) * 1024 + n0;
        *(u32x4*)((bf16_t*)(ws + WS_UT) + off) = pack8(e0, e1);
        *(u32x4*)((bf16_t*)(ws + WS_UT) + (size_t)16 * 512 * 1024 + off) = pack8(o0, o1);
    }
};
struct DftPre { f32x4 c[4]; };
struct EpiDft : EpiBase {
    typedef DftPre Pre; static constexpr int MB = 2;
    unsigned char* ws;
    __device__ __forceinline__ void load(const Unit& u, int lrow, int colq, DftPre& q) {
        const float* p = (const float*)(ws + WS_U1024) + u.aux * 512 + u.c0 + colq;
        q.c[0] = *(const f32x4*)p; q.c[1] = *(const f32x4*)(p + 4); q.c[2] = *(const f32x4*)(p + 32); q.c[3] = *(const f32x4*)(p + 36);
    }
    __device__ __forceinline__ void pair8(const Unit& u, int lrow, int colq, f32x4 a0, f32x4 a1, f32x4 b0, f32x4 b1, const DftPre& q) {
        const int row = u.r0 + lrow, pos = row & 2047; if (pos == 1024) return;
        if (pos < 1024) { const float sg = (pos & 1) ? -1.f : 1.f; a0 += sg * q.c[0]; a1 += sg * q.c[1]; b0 += sg * q.c[2]; b1 += sg * q.c[3]; }
        bf16_t* p = (bf16_t*)(ws + WS_R) + (size_t)row * 512 + u.c0 + colq; *(u32x4*)p = pack8(a0, a1); *(u32x4*)(p + 32) = pack8(b0, b1);
    }
};
struct EpiScan : EpiBase {
    static constexpr bool AFTER_DRAIN = true;
    unsigned char* ws; LAS float* ebuf;
    __device__ __forceinline__ void pair8(const Unit&, int lrow, int colq, f32x4 a0, f32x4 a1, f32x4 b0, f32x4 b1, const Pre&) {
        LAS float* p = ebuf + (lrow & 127) * 260 + colq; *(LAS f32x4*)p = a0; *(LAS f32x4*)(p + 4) = a1; *(LAS f32x4*)(p + 32) = b0; *(LAS f32x4*)(p + 36) = b1;
    }
    __device__ __forceinline__ void half_done(const Unit& u, int ai) {
        LDS_WAIT(); __syncthreads();
        const int tid = threadIdx.x;
        if (tid < 256) {
            const int dir = tid >> 7, part = (tid >> 6) & 1, p = tid & 63, g = u.aux;
            const f32x2 aL = ((const f32x2*)(ws + WS_AL))[(g * 2 + dir) * 64 + p];
            const int seq = (u.r0 >> 7) + ai;
            bf16_t* xrow = (bf16_t*)(ws + WS_XS) + ((size_t)g * 2048 + seq * 128) * 512 + 256 + tid;
            const LAS float* e = ebuf + dir * 128 + p;
            float sr = 0.f, si = 0.f;
            for (int blk = 0; blk < 8; ++blk) {
                float er[16], ei[16];
#pragma unroll
                for (int j = 0; j < 16; ++j) { const int c = dir ? 127 - (blk * 16 + j) : blk * 16 + j; er[j] = e[c * 260]; ei[j] = e[c * 260 + 64]; }
#pragma unroll
                for (int j = 0; j < 16; ++j) { const int c = dir ? 127 - (blk * 16 + j) : blk * 16 + j;
                    const float o = part ? si : sr;
                    xrow[(size_t)c * 512] = (bf16_t)(cvt_pk_bf16(o, 0.f) & 0xffffu);
                    const float nr = aL.x * sr - aL.y * si + er[j], ni = aL.x * si + aL.y * sr + ei[j];
                    sr = nr; si = ni; }
            }
        }
        __syncthreads();
    }
};
struct EpiYS : EpiBase {
    unsigned char* ws;
    __device__ __forceinline__ void pair8(const Unit& u, int lrow, int colq, f32x4 a0, f32x4 a1, f32x4 b0, f32x4 b1, const Pre&) {
        const int idx = u.r0 + lrow, b = idx >> 7, c = idx & 127;
#pragma unroll
        for (int bj = 0; bj < 2; ++bj) { const int col = colq + bj * 32, i = col >> 4, h = col & 15; f32x4 lo = bj ? b0 : a0, hi = bj ? b1 : a1;
#pragma unroll
            for (int q = 0; q < 4; ++q) { lo[q] = gelu_tanh(lo[q]); hi[q] = gelu_tanh(hi[q]); }
            bf16_t* p = (bf16_t*)(ws + WS_YS) + (size_t)(b * 2048 + c * 16 + i) * 512 + u.aux * 16 + h; *(u32x4*)p = pack8(lo, hi); }
    }
};
struct EpiFnet : EpiBase {
    bf16_t* O;
    __device__ __forceinline__ void pair8(const Unit& u, int lrow, int colq, f32x4 a0, f32x4 a1, f32x4 b0, f32x4 b1, const Pre&) {
        const int row = u.r0 + lrow; if ((row & 2047) == 1024) return;
        bf16_t* p = O + (size_t)row * 1024 + u.c0 + colq; *(u32x4*)p = pack8(a0, a1); *(u32x4*)(p + 32) = pack8(b0, b1);
    }
};
struct EpiP1All : EpiBase {
    unsigned char* ws;
    __device__ __forceinline__ void pair8(const Unit& u, int lrow, int colq, f32x4 a0, f32x4 a1, f32x4 b0, f32x4 b1, const Pre& p) {
        if (u.sub == 0) { EpiP1Main E; E.ws = ws; E.pair8(u, lrow, colq, a0, a1, b0, b1, p); } else { EpiP1Swap E; E.ws = ws; E.pair8(u, lrow, colq, a0, a1, b0, b1, p); }
    }
};
struct EpiP3All : EpiBase {
    unsigned char* ws; bf16_t* Y;
    __device__ __forceinline__ void pair8(const Unit& u, int lrow, int colq, f32x4 a0, f32x4 a1, f32x4 b0, f32x4 b1, const Pre& p) {
        if (u.sub == 0) { EpiYS E; E.ws = ws; E.pair8(u, lrow, colq, a0, a1, b0, b1, p); } else { EpiFnet E; E.O = Y; E.pair8(u, lrow, colq, a0, a1, b0, b1, p); }
    }
};
struct EpiGluM : EpiBase {
    static constexpr bool WHOLE_TILE = true;
    unsigned char* ws; const bf16_t* Y;
    __device__ __forceinline__ void pair8(const Unit&, int, int, f32x4, f32x4, f32x4, f32x4, const Pre&) {}
    __device__ __forceinline__ void tile(f32x4 (&acc)[2][2][4][2], const Unit& u, int wr, int wc, int fr, int fq) {
        const int oc = u.c0 + wc * 32 + fq * 8;
        u32x4 y1[4], y2[4]; u32x2 za[4][2], zb[4][2];
#pragma unroll
        for (int m = 0; m < 4; ++m) { const int k = u.aux * 128 + wr * 64 + m * 16 + fr, tA = u.r0 + k, tB = u.r0 + (k == 0 ? 1024 : 2048 - k);
            y1[m] = *(const u32x4*)(Y + (size_t)tA * 1024 + oc); y2[m] = *(const u32x4*)(Y + (size_t)(tA + 1024) * 1024 + oc);
            za[m][0] = *(const u32x2*)(ws + WS_ZA + (size_t)tA * 1024 + oc); zb[m][0] = *(const u32x2*)(ws + WS_ZB + (size_t)tA * 1024 + oc);
            za[m][1] = *(const u32x2*)(ws + WS_ZA + (size_t)tB * 1024 + oc); zb[m][1] = *(const u32x2*)(ws + WS_ZB + (size_t)tB * 1024 + oc); }
#pragma unroll
        for (int m = 0; m < 4; ++m) { const int k = u.aux * 128 + wr * 64 + m * 16 + fr, tA = u.r0 + k, tB = u.r0 + (k == 0 ? 1024 : 2048 - k);
            const f32x4 p_lo = unpack_lo(y1[m]), p_hi = unpack_hi(y1[m]), q_lo = unpack_lo(y2[m]), q_hi = unpack_hi(y2[m]);
            const f32x4 ybA_lo = k == 0 ? p_lo : p_lo - q_lo, ybA_hi = k == 0 ? p_hi : p_hi - q_hi, ybB_lo = k == 0 ? q_lo : p_lo + q_lo, ybB_hi = k == 0 ? q_hi : p_hi + q_hi;
            const f32x4 a_lo = dq8x4(za[m][0].x) * (acc[0][0][m][0] * sigmoid4(acc[0][1][m][0])) + dq8x4(zb[m][0].x) * ybA_lo;
            const f32x4 a_hi = dq8x4(za[m][0].y) * (acc[0][0][m][1] * sigmoid4(acc[0][1][m][1])) + dq8x4(zb[m][0].y) * ybA_hi;
            *(u32x4*)((bf16_t*)(ws + WS_MG) + (size_t)tA * 1024 + oc) = pack8(a_lo, a_hi);
            const f32x4 b_lo = dq8x4(za[m][1].x) * (acc[1][0][m][0] * sigmoid4(acc[1][1][m][0])) + dq8x4(zb[m][1].x) * ybB_lo;
            const f32x4 b_hi = dq8x4(za[m][1].y) * (acc[1][0][m][1] * sigmoid4(acc[1][1][m][1])) + dq8x4(zb[m][1].y) * ybB_hi;
            *(u32x4*)((bf16_t*)(ws + WS_MG) + (size_t)tB * 1024 + oc) = pack8(b_lo, b_hi); }
    }
};
struct ResPre0 { u32x4 a, b; float s; };
struct ResPre1 { u32x4 a, b; };
template <int WHICH> struct EpiRes : EpiBase {
    typedef typename std::conditional<WHICH == 0, ResPre0, ResPre1>::type Pre; static constexpr int MB = 4;
    const float* x; unsigned char* ws; float ss;
    __device__ __forceinline__ void load(const Unit& u, int lrow, int colq, Pre& q) {
        const size_t off = (size_t)(u.r0 + lrow) * 1024 + u.c0 + colq;
        if constexpr (WHICH == 0) { const bf16_t* xn = (const bf16_t*)(ws + WS_XN) + off; q.a = *(const u32x4*)xn; q.b = *(const u32x4*)(xn + 32); q.s = ((const float*)(ws + WS_INVR))[u.r0 + lrow]; }
        else { const bf16_t* xb = (const bf16_t*)(ws + WS_XB) + off; q.a = *(const u32x4*)xb; q.b = *(const u32x4*)(xb + 32); }
    }
    __device__ __forceinline__ void row_begin() { ss = 0.f; }
    __device__ __forceinline__ void pair8(const Unit& u, int lrow, int colq, f32x4 a0, f32x4 a1, f32x4 b0, f32x4 b1, const Pre& q) {
        const size_t off = (size_t)(u.r0 + lrow) * 1024 + u.c0 + colq;
        if constexpr (WHICH == 0) { a0 += unpack_lo(q.a) * q.s; a1 += unpack_hi(q.a) * q.s; b0 += unpack_lo(q.b) * q.s; b1 += unpack_hi(q.b) * q.s; } else { a0 += unpack_lo(q.a); a1 += unpack_hi(q.a); b0 += unpack_lo(q.b); b1 += unpack_hi(q.b); }
        bf16_t* xb = (bf16_t*)(ws + WS_XB) + off; *(u32x4*)xb = pack8(a0, a1); *(u32x4*)(xb + 32) = pack8(b0, b1);
        const f32x4 s4 = a0 * a0 + a1 * a1 + b0 * b0 + b1 * b1; ss += (s4[0] + s4[1]) + (s4[2] + s4[3]);
    }
    __device__ __forceinline__ void row_end(const Unit& u, int lrow, int slot, int nslots) {
        float s = ss; s += __shfl_xor(s, 16); s += __shfl_xor(s, 32);
        if ((threadIdx.x & 63) < 16) { float* p = (float*)(ws + (WHICH ? WS_SSP2 : WS_SSP1)) + (size_t)(u.r0 + lrow) * 16 + (u.c0 >> 8) * 4;
            if (nslots == 1) *(f32x4*)p = (f32x4){s, 0.f, 0.f, 0.f}; else p[slot] = s; }
    }
};
struct EpiUp : EpiBase {
    unsigned char* ws; const LAS float* rs; bf16_t* hlo;
    __device__ __forceinline__ void pair8(const Unit& u, int lrow, int colq, f32x4 a0, f32x4 a1, f32x4 b0, f32x4 b1, const Pre&) {
        const float r = rs[u.slot * 256 + lrow];
        a0 *= r; a1 *= r; b0 *= r; b1 *= r;
#pragma unroll
        for (int j = 0; j < 4; ++j) { a0[j] = a0[j] > 0.f ? a0[j] * a0[j] : 0.f; a1[j] = a1[j] > 0.f ? a1[j] * a1[j] : 0.f; b0[j] = b0[j] > 0.f ? b0[j] * b0[j] : 0.f; b1[j] = b1[j] > 0.f ? b1[j] * b1[j] : 0.f; }
        bf16_t* p = (u.c0 < 2048 ? hlo + u.c0 : (bf16_t*)(ws + WS_HHI) + (u.c0 - 2048)) + (size_t)(u.r0 + lrow) * 2048 + colq; *(u32x4*)p = pack8(a0, a1); *(u32x4*)(p + 32) = pack8(b0, b1);
    }
};
struct EpiFinal : EpiBase {
    static constexpr bool WHOLE_TILE = true;
    unsigned char* ws; float* out; const LAS float* rs; const float* gfin;
    __device__ __forceinline__ void pair8(const Unit&, int, int, f32x4, f32x4, f32x4, f32x4, const Pre&) {}
    __device__ __forceinline__ void tile(f32x4 (&acc)[2][2][4][2], const Unit& u, int wr, int wc, int fr, int fq) {
        float* ss3 = (float*)(ws + WS_CTL + CTL_SS3); unsigned* cnt = (unsigned*)(ws + WS_CTL + CTL_CNT) + (u.r0 >> 8) * 64;
        const int colb = u.c0 + wc * 64 + fq * 8;
        u32x4 pk[2][4][2];
#pragma unroll
        for (int ai = 0; ai < 2; ++ai)
#pragma unroll
            for (int m = 0; m < 4; ++m) {
                const int lrow = ai * 128 + wr * 64 + m * 16 + fr; const size_t off = (size_t)(u.r0 + lrow) * 1024 + colb;
                const bf16_t* xb = (const bf16_t*)(ws + WS_XB) + off; const bf16_t* pp = (const bf16_t*)(ws + WS_PP) + off;
                const u32x4 x0 = *(const u32x4*)xb, x1 = *(const u32x4*)(xb + 32), p0 = *(const u32x4*)pp, p1 = *(const u32x4*)(pp + 32);
                const float r = rs[u.slot * 256 + lrow];
                const f32x4 a0 = unpack_lo(x0) + sigmoid4(acc[ai][0][m][0] * r) * unpack_lo(p0), a1 = unpack_hi(x0) + sigmoid4(acc[ai][0][m][1] * r) * unpack_hi(p0);
                const f32x4 b0 = unpack_lo(x1) + sigmoid4(acc[ai][1][m][0] * r) * unpack_lo(p1), b1 = unpack_hi(x1) + sigmoid4(acc[ai][1][m][1] * r) * unpack_hi(p1);
                pk[ai][m][0] = pack8(a0, a1); pk[ai][m][1] = pack8(b0, b1);
                const f32x4 s4 = a0 * a0 + a1 * a1 + b0 * b0 + b1 * b1; float s = (s4[0] + s4[1]) + (s4[2] + s4[3]);
                s += __shfl_xor(s, 16); s += __shfl_xor(s, 32);
                if (fq == 0) (void)__hip_atomic_fetch_add(ss3 + u.r0 + lrow, s, __ATOMIC_RELAXED, __HIP_MEMORY_SCOPE_AGENT);
                asm volatile("" ::: "memory");
            }
        asm volatile("s_waitcnt vmcnt(0)" ::: "memory");
        if ((threadIdx.x & 63) == 0) (void)__hip_atomic_fetch_add(cnt, 1u, __ATOMIC_RELAXED, __HIP_MEMORY_SCOPE_AGENT);
        { unsigned sp = 0; while ((unsigned)__builtin_amdgcn_readfirstlane(__hip_atomic_load(cnt, __ATOMIC_RELAXED, __HIP_MEMORY_SCOPE_AGENT)) < 32u) { __builtin_amdgcn_s_sleep(2); if (++sp > (1u << 22)) break; } }
        f32x4 gv[2][2];
#pragma unroll
        for (int bj = 0; bj < 2; ++bj)
#pragma unroll
            for (int n = 0; n < 2; ++n) gv[bj][n] = *(const f32x4*)(gfin + colb + bj * 32 + n * 4);
#pragma unroll
        for (int ai = 0; ai < 2; ++ai)
#pragma unroll
            for (int m = 0; m < 4; ++m) { const int row = u.r0 + ai * 128 + wr * 64 + m * 16 + fr;
                const float tot = __hip_atomic_load(ss3 + row, __ATOMIC_RELAXED, __HIP_MEMORY_SCOPE_AGENT), rstd = 1.0f / sqrtf(tot * (1.0f / D) + EPS);
                float* o = out + (size_t)row * 1024 + colb;
                *(f32x4*)o = unpack_lo(pk[ai][m][0]) * rstd * gv[0][0]; *(f32x4*)(o + 4) = unpack_hi(pk[ai][m][0]) * rstd * gv[0][1];
                *(f32x4*)(o + 32) = unpack_lo(pk[ai][m][1]) * rstd * gv[1][0]; *(f32x4*)(o + 36) = unpack_hi(pk[ai][m][1]) * rstd * gv[1][1]; }
    }
};

__device__ __forceinline__ int perm32(int rho) { const int n = rho >> 4, i = rho & 15; return 8 * (i >> 2) + 4 * n + (i & 3); }
template <class Epi, class SegT>
__device__ __forceinline__ void gemm_simple(const SegT& S, Epi& E) {
    const int tid = threadIdx.x, wave = __builtin_amdgcn_readfirstlane(tid >> 6), lane = tid & 63, fr = lane & 15, fq = lane >> 4;
    constexpr int lda = SegT::lda(), ldb = SegT::ldb(), K = SegT::K();
    static_assert(!SegT::CUSTOMA && !SegT::SPLITA && !Epi::WHOLE_TILE, "the simple body has no mirrored-row staging and no whole-tile epilogue: run this segment on the fast body");
    Unit u;
    for (int i = 0; S.next(i, u); ++i) {
        for (int ai = 0; ai < 2; ++ai) {
            const int lrow = ai * 128 + wave * 16 + fr;
            const bf16_t* ap = u.A + (size_t)lrow * lda + fq * 8;
            E.row_begin();
            for (int wc = 0; wc < 4; ++wc) {
                f32x4 acc[2][2];
#pragma unroll
                for (int bj = 0; bj < 2; ++bj)
#pragma unroll
                    for (int n = 0; n < 2; ++n) {
                        int brow = wc * 64 + bj * 32 + perm32(n * 16 + fr);
                        if constexpr (SegT::CUSTOMB) { const int pos = u.c0 + wc * 32 + perm32(n * 16 + fr); brow = bj ? (pos == 0 ? 1024 : 2048 - pos) : pos; }
                        const bf16_t* bp = u.B + (size_t)brow * ldb + fq * 8;
                        f32x4 a = {0.f, 0.f, 0.f, 0.f};
#pragma unroll 4
                        for (int k = 0; k < K; k += 32) a = __builtin_amdgcn_mfma_f32_16x16x32_bf16(*(const bf16x8*)(bp + k), *(const bf16x8*)(ap + k), a, 0, 0, 0);
                        acc[bj][n] = a;
                    }
                typename Epi::Pre pre; E.load(u, lrow, wc * 64 + fq * 8, pre);
                E.pair8(u, lrow, wc * 64 + fq * 8, acc[0][0], acc[0][1], acc[1][0], acc[1][1], pre);
            }
            E.row_end(u, lrow, 0, 1);
            E.half_done(u, ai);
        }
    }
}

constexpr int BM = 256, BK = 64, HALF = 128, HTB = HALF * BK * 2;
__device__ __forceinline__ int lds_byte(int r, int c) { const int st = (r >> 4) * 2 + (c >> 5), rr = r & 15, cc = c & 31, ob = rr * 64 + cc * 2; return st * 1024 + (ob ^ (((ob >> 9) & 1) << 5)); }
__device__ __forceinline__ void stage_rc(int b, int& R, int& C) { const int st = b / 1024, sb = b % 1024, swz = sb ^ (((sb >> 9) & 1) << 5); R = (st >> 1) * 16 + swz / 64; C = (st & 1) * 32 + (swz % 64) / 2; }

#ifndef PG8_ALIGN
#define PG8_ALIGN true
#endif
#ifndef PG8_SP2
#define PG8_SP2 true
#endif
struct NoHook { __device__ __forceinline__ void operator()() const {} };
template <class Epi, class SegT, class Hook = NoHook, bool ALIGN_EPI = PG8_ALIGN, bool SP2 = PG8_SP2>
__device__ __forceinline__ void gemm_fast(LAS unsigned char* lds, const SegT& S, Epi& E, const Hook& hook = Hook()) {
    const int tid = threadIdx.x, wid = __builtin_amdgcn_readfirstlane(tid >> 6), lane = tid & 63, wr = wid >> 2, wc = wid & 3, fr = lane & 15, fq = lane >> 4;
    constexpr int lda = SegT::lda(), ldb = SegT::ldb(), K = SegT::K(), nt = K / BK;
    unsigned voffA[2], voffB0[2], voffB1[2];
#pragma unroll
    for (int i = 0; i < 2; ++i) { int R, C; stage_rc(tid * 16 + i * 8192, R, C); voffA[i] = (unsigned)(R * lda + C) * 2u;
        const int Rb = (R >> 5) * 64 + perm32(R & 31); voffB0[i] = (unsigned)(Rb * ldb + C) * 2u; voffB1[i] = (unsigned)((Rb + 32) * ldb + C) * 2u; }
    constexpr size_t kstep = (size_t)(BK * 2);
    constexpr size_t hstepA = (size_t)HALF * lda * 2;
    int voffAh[2], voffAhS[2];
#pragma unroll
    for (int i = 0; i < 2; ++i) { int R, C; stage_rc(tid * 16 + i * 8192, R, C); voffAh[i] = ((127 - R) * lda + C) * 2; voffAhS[i] = voffAh[i] - (R == 0 ? 1024 * lda * 2 : 0); }
#define PG8_STAGE_AH(bufoff, base_lo, base_hi, special) do { if constexpr (SegT::CUSTOMA) { _Pragma("unroll") for (int _i = 0; _i < 2; ++_i) \
        __builtin_amdgcn_global_load_lds((const unsigned*)((const char*)(base_hi) + (long)((special) ? voffAhS[_i] : voffAh[_i])), (LAS unsigned*)(lds + (bufoff) + ldsw + _i * 8192), 16, 0, 0); } \
        else { PG8_STAGE(bufoff, (const char*)(base_lo) + hstepA, voffA); } } while (0)
    const unsigned ldsw = (unsigned)wid * 1024u;
    const int aoff = lds_byte(wr * 64 + fr, fq * 8), boff = lds_byte(wc * 32 + fr, fq * 8);
#define PG8_SA(b, h) (((b) * 2 + (h)) * HTB)
#define PG8_SB(b, h) ((4 + (b) * 2 + (h)) * HTB)
#define PG8_STAGE(bufoff, gbase, voff) do { _Pragma("unroll") for (int _i = 0; _i < 2; ++_i) \
        __builtin_amdgcn_global_load_lds((const unsigned*)((const char*)(gbase) + (voff)[_i]), (LAS unsigned*)(lds + (bufoff) + ldsw + _i * 8192), 16, 0, 0); } while (0)
#define PG8_LDA(dst, b, h) do { _Pragma("unroll") for (int m = 0; m < 4; ++m) _Pragma("unroll") for (int k = 0; k < 2; ++k) dst[m][k] = *(const LAS bf16x8*)(lds + PG8_SA(b, h) + aoff + m * 2048 + k * 1024); } while (0)
#define PG8_LDB(dst, b, h) do { _Pragma("unroll") for (int n = 0; n < 2; ++n) _Pragma("unroll") for (int k = 0; k < 2; ++k) dst[n][k] = *(const LAS bf16x8*)(lds + PG8_SB(b, h) + boff + n * 2048 + k * 1024); } while (0)
#define PG8_MMA(ai, bj, At, Bt) do { __builtin_amdgcn_s_setprio(1); _Pragma("unroll") for (int m = 0; m < 4; ++m) _Pragma("unroll") for (int n = 0; n < 2; ++n) _Pragma("unroll") for (int k = 0; k < 2; ++k) \
        acc[ai][bj][m][n] = __builtin_amdgcn_mfma_f32_16x16x32_bf16(Bt[n][k], At[m][k], acc[ai][bj][m][n], 0, 0, 0); __builtin_amdgcn_s_setprio(0); } while (0)
#define PG8_WAIT_V(n) asm volatile("s_waitcnt vmcnt(" #n ")" ::: "memory")
#define PG8_WAIT_L(n) asm volatile("s_waitcnt lgkmcnt(" #n ")" ::: "memory")
#define PG8_BAR __builtin_amdgcn_s_barrier()
#define PG8_SCHED __builtin_amdgcn_sched_barrier(0)
#define PG8_EPILOGUE() do { if constexpr (Epi::WHOLE_TILE) { static_assert(!Epi::WHOLE_TILE || ALIGN_EPI, "the exchange in a whole-tile epilogue needs both half-workgroups in the epilogue together"); E.tile(acc, cur, wr, wc, fr, fq); } else { _Pragma("unroll") for (int ai = 0; ai < 2; ++ai) { _Pragma("unroll") for (int mb = 0; mb < 4; mb += Epi::MB) { typename Epi::Pre pre[Epi::MB]; \
        _Pragma("unroll") for (int mm = 0; mm < Epi::MB; ++mm) E.load(cur, ai * HALF + wr * 64 + (mb + mm) * 16 + fr, wc * 64 + fq * 8, pre[mm]); \
        _Pragma("unroll") for (int mm = 0; mm < Epi::MB; ++mm) { const int lrow = ai * HALF + wr * 64 + (mb + mm) * 16 + fr; E.row_begin(); \
            E.pair8(cur, lrow, wc * 64 + fq * 8, acc[ai][0][mb + mm][0], acc[ai][0][mb + mm][1], acc[ai][1][mb + mm][0], acc[ai][1][mb + mm][1], pre[mm]); E.row_end(cur, lrow, wc, 4); } } E.half_done(cur, ai); } } } while (0)
    Unit cur, nxt; int ui = 0;
    if (!S.next(0, cur)) return;
    if constexpr (SegT::CUSTOMB) {
#pragma unroll
        for (int i = 0; i < 2; ++i) { int R, C; stage_rc(tid * 16 + i * 8192, R, C); const int pos = cur.c0 + (R >> 5) * 32 + perm32(R & 31), mir = pos == 0 ? 1024 : 2048 - pos;
            voffB0[i] = (unsigned)(pos * ldb + C) * 2u; voffB1[i] = (unsigned)(mir * ldb + C) * 2u; }
    }
    f32x4 acc[2][2][4][2];
#pragma unroll
    for (int a = 0; a < 2; ++a)
#pragma unroll
        for (int b = 0; b < 2; ++b)
#pragma unroll
            for (int m = 0; m < 4; ++m)
#pragma unroll
                for (int n = 0; n < 2; ++n) acc[a][b][m][n] = (f32x4){0.f, 0.f, 0.f, 0.f};
    bf16x8 At[4][2], B0[2][2], B1[2][2];
    const char* cA = (const char*)cur.A; const char* cB = (const char*)cur.B; const char* cA2 = SegT::CUSTOMA ? (const char*)cur.A2 : cA;
    const char* cAhi = SegT::SPLITA ? (const char*)cur.A2 - (size_t)(nt / 2) * (size_t)(BK * 2) : cA;
    if constexpr (SP2) {
        PG8_STAGE(PG8_SB(0, 0), cB, voffB0); PG8_STAGE(PG8_SB(0, 1), cB, voffB1); PG8_STAGE(PG8_SA(0, 0), cA, voffA); PG8_STAGE_AH(PG8_SA(0, 1), cA, cA2, cur.sub != 0);
        hook();
        if (wr == 1) PG8_BAR;
        PG8_WAIT_V(2); PG8_BAR;
        PG8_STAGE(PG8_SB(1, 0), cB + kstep, voffB0); PG8_STAGE(PG8_SA(1, 0), cA + kstep, voffA); PG8_STAGE(PG8_SB(1, 1), cB + kstep, voffB1);
        PG8_WAIT_V(6); PG8_BAR;
    } else {
        PG8_STAGE(PG8_SB(0, 0), cB, voffB0); PG8_STAGE(PG8_SA(0, 0), cA, voffA); PG8_STAGE(PG8_SB(0, 1), cB, voffB1); PG8_STAGE_AH(PG8_SA(0, 1), cA, cA2, cur.sub != 0);
        if (wr == 1) PG8_BAR;
        PG8_WAIT_V(4); PG8_BAR;
        PG8_STAGE(PG8_SB(1, 0), cB + kstep, voffB0); PG8_STAGE(PG8_SA(1, 0), cA + kstep, voffA); PG8_STAGE(PG8_SB(1, 1), cB + kstep, voffB1);
        PG8_WAIT_V(6); PG8_BAR;
    }
    for (;;) {
        const bool has_next = S.next(ui + 1, nxt);
        const char* nA = has_next ? (const char*)nxt.A : cA; const char* nB = has_next ? (const char*)nxt.B : cB;
        const char* nA2 = SegT::CUSTOMA ? (has_next ? (const char*)nxt.A2 : cA2) : nA; const bool nsub = has_next ? (nxt.sub != 0) : (cur.sub != 0);
        const char* nAhi = SegT::SPLITA ? (has_next ? (const char*)nxt.A2 - (size_t)(nt / 2) * (size_t)(BK * 2) : cAhi) : nA;
        _Pragma("nounroll") for (int t = 0; t < nt; t += 2) {
            const bool last = (t == nt - 2);
            const char* sd0 = (SegT::SPLITA && t >= nt / 2) ? cAhi : cA; const char* sd2 = (SegT::SPLITA && t + 2 >= nt / 2) ? cAhi : cA;
            const char* a1 = sd0 + (size_t)(t + 1) * kstep;
            const char* a2 = last ? nA : sd2 + (size_t)(t + 2) * kstep; const char* b2 = last ? nB : cB + (size_t)(t + 2) * kstep;
            const char* a3 = a2 + kstep; const char* b3 = b2 + kstep;
            const char* a1h = cA2 + (size_t)(t + 1) * kstep; const char* a2h = last ? nA2 : cA2 + (size_t)(t + 2) * kstep; const bool s1 = cur.sub != 0, s2 = last ? nsub : (cur.sub != 0);
            if constexpr (SP2) {
            PG8_LDB(B0, 0, 0); PG8_LDB(B1, 0, 1); PG8_SCHED; PG8_LDA(At, 0, 0); PG8_STAGE_AH(PG8_SA(1, 1), a1, a1h, s1);
            PG8_WAIT_V(8); PG8_WAIT_L(0); PG8_BAR; PG8_MMA(0, 0, At, B0); PG8_MMA(0, 1, At, B1); PG8_BAR; PG8_SCHED;
            PG8_LDA(At, 0, 1); PG8_STAGE(PG8_SB(0, 0), b2, voffB0); PG8_STAGE(PG8_SB(0, 1), b2, voffB1); PG8_STAGE(PG8_SA(0, 0), a2, voffA);
            PG8_WAIT_V(8); PG8_WAIT_L(0); PG8_BAR; PG8_MMA(1, 0, At, B0); PG8_MMA(1, 1, At, B1); PG8_BAR; PG8_SCHED;
            PG8_LDB(B0, 1, 0); PG8_LDB(B1, 1, 1); PG8_SCHED; PG8_LDA(At, 1, 0); PG8_STAGE_AH(PG8_SA(0, 1), a2, a2h, s2);
            PG8_WAIT_V(8); PG8_WAIT_L(0); PG8_BAR; PG8_MMA(0, 0, At, B0); PG8_MMA(0, 1, At, B1); PG8_BAR; PG8_SCHED;
            PG8_LDA(At, 1, 1); PG8_STAGE(PG8_SB(1, 0), b3, voffB0); PG8_STAGE(PG8_SB(1, 1), b3, voffB1); PG8_STAGE(PG8_SA(1, 0), a3, voffA);
            PG8_WAIT_V(8); PG8_WAIT_L(0); PG8_BAR; PG8_MMA(1, 0, At, B0); PG8_MMA(1, 1, At, B1); PG8_BAR; PG8_SCHED;
            } else {
            PG8_LDB(B0, 0, 0); PG8_SCHED; PG8_LDA(At, 0, 0); PG8_STAGE_AH(PG8_SA(1, 1), a1, a1h, s1);
            PG8_WAIT_L(8); PG8_BAR; PG8_WAIT_L(0); PG8_MMA(0, 0, At, B0); PG8_BAR; PG8_SCHED;
            PG8_LDB(B1, 0, 1); PG8_STAGE(PG8_SB(0, 0), b2, voffB0);
            PG8_BAR; PG8_WAIT_L(0); PG8_MMA(0, 1, At, B1); PG8_BAR;
            PG8_LDA(At, 0, 1); PG8_STAGE(PG8_SA(0, 0), a2, voffA);
            PG8_BAR; PG8_WAIT_L(0); PG8_MMA(1, 0, At, B0); PG8_BAR; PG8_SCHED;
            PG8_STAGE(PG8_SB(0, 1), b2, voffB1);
            PG8_WAIT_V(6); PG8_BAR; PG8_MMA(1, 1, At, B1); PG8_BAR;
            PG8_LDB(B0, 1, 0); PG8_SCHED; PG8_LDA(At, 1, 0); PG8_STAGE_AH(PG8_SA(0, 1), a2, a2h, s2);
            PG8_WAIT_L(8); PG8_BAR; PG8_WAIT_L(0); PG8_MMA(0, 0, At, B0); PG8_BAR; PG8_SCHED;
            PG8_LDB(B1, 1, 1); PG8_STAGE(PG8_SB(1, 0), b3, voffB0);
            PG8_BAR; PG8_WAIT_L(0); PG8_MMA(0, 1, At, B1); PG8_BAR;
            PG8_LDA(At, 1, 1); PG8_STAGE(PG8_SA(1, 0), a3, voffA);
            PG8_BAR; PG8_WAIT_L(0); PG8_MMA(1, 0, At, B0); PG8_BAR; PG8_SCHED;
            PG8_STAGE(PG8_SB(1, 1), b3, voffB1);
            PG8_WAIT_V(6); PG8_BAR; PG8_MMA(1, 1, At, B1); PG8_BAR;
            }
        }
        if constexpr (ALIGN_EPI) { if (wr == 0) PG8_BAR; }
        if constexpr (!Epi::AFTER_DRAIN) { PG8_EPILOGUE(); }
        if (!has_next) break;
#pragma unroll
        for (int a = 0; a < 2; ++a)
#pragma unroll
            for (int b = 0; b < 2; ++b)
#pragma unroll
                for (int m = 0; m < 4; ++m)
#pragma unroll
                    for (int n = 0; n < 2; ++n) acc[a][b][m][n] = (f32x4){0.f, 0.f, 0.f, 0.f};
        cur = nxt; cA = nA; cB = nB; cA2 = nA2; cAhi = nAhi; ++ui;
        if constexpr (ALIGN_EPI) { if (wr == 1) PG8_BAR; }
    }
    PG8_WAIT_V(0);
    if constexpr (!ALIGN_EPI) { if (wr == 0) PG8_BAR; }
    PG8_BAR;
    if constexpr (Epi::AFTER_DRAIN) { PG8_EPILOGUE(); }
#undef PG8_SA
#undef PG8_SB
#undef PG8_STAGE
#undef PG8_STAGE_AH
#undef PG8_LDA
#undef PG8_LDB
#undef PG8_MMA
#undef PG8_WAIT_V
#undef PG8_WAIT_L
#undef PG8_BAR
#undef PG8_SCHED
#undef PG8_EPILOGUE
}

template <int KIND, class Epi, class Hook = NoHook>
__device__ __forceinline__ void run_segment(LAS unsigned char* lds, unsigned char* ws, int G, Epi& E, const Hook& hook = Hook(), const void* ext = nullptr) {
    Seg<KIND> S; S.ws = ws; S.G = G; S.c = blockIdx.x; S.only = -1; S.ext = ext;
    if constexpr ((FAST_MASK >> KIND) & 1) {
        if constexpr (Epi::AFTER_DRAIN || Seg<KIND>::CUSTOMB) { hook(); const int n = S.count(); for (int i = 0; i < n; ++i) { S.only = i; gemm_fast<Epi, Seg<KIND>>(lds, S, E); } }
        else gemm_fast<Epi, Seg<KIND>, Hook>(lds, S, E, hook);
        __syncthreads();
    } else {
        hook(); gemm_simple<Epi, Seg<KIND>>(S, E);
    }
}

__device__ __forceinline__ void transpose_item(const float* W, int K, int N, bf16_t* WT, const float* gk, int glu_map, LAS float* scr, int item, int lane) {
    const int nblk = N / 32, kb = item / nblk, nb = item % nblk, k0 = 64 * kb, n0 = 32 * nb;
    float tv[32];
#pragma unroll
    for (int i = 0; i < 32; ++i) { const int kk = 2 * i + (lane >> 5); tv[i] = W[(size_t)(k0 + kk) * N + n0 + (lane & 31)]; }
#pragma unroll
    for (int i = 0; i < 32; ++i) { const int kk = 2 * i + (lane >> 5); float v = tv[i]; if (gk) v *= gk[k0 + kk]; scr[kk * 33 + (lane & 31)] = v; }
    LDS_WAIT(); asm volatile("" ::: "memory");
    int d0 = n0;
    if (glu_map) { const int v = n0 < 1024 ? n0 : n0 - 1024; d0 = (v >> 7) * 256 + ((v >> 5) & 3) * 64 + (n0 < 1024 ? 0 : 32); }
    const int c = lane & 7;
#pragma unroll
    for (int j = 0; j < 4; ++j) { const int n = (lane >> 3) + 8 * j; const LAS float* s = scr + (8 * c) * 33 + n;
        u32x4 o; o.x = cvt_pk_bf16(s[0 * 33], s[1 * 33]); o.y = cvt_pk_bf16(s[2 * 33], s[3 * 33]); o.z = cvt_pk_bf16(s[4 * 33], s[5 * 33]); o.w = cvt_pk_bf16(s[6 * 33], s[7 * 33]);
        *(u32x4*)(WT + (size_t)(d0 + n) * K + k0 + 8 * c) = o; }
    LDS_WAIT(); asm volatile("" ::: "memory");
}

struct In { const float *x, *p, *g_mix, *w_in, *lam_re, *lam_im, *log_dt, *b_re, *b_im, *c_re, *c_im, *d_skip, *w_glu, *w_fnet, *w_out, *g_ffn, *w_up, *w_down, *g_ple, *w_ple_gate, *w_ple, *g_final; };

template <int NI>
__device__ __forceinline__ void s5_tables(const In& in, unsigned char* ws, LAS unsigned char* lds, int gp0, int gp1) {
    constexpr int ISZ = 17408 + 16384 + 16384 + 4096;
    const int tid = threadIdx.x;
    float s1_lr = 0.f, s1_li = 0.f, s1_ldt = 0.f;
    const int it1 = (tid >> 7) & (NI - 1), gp_1 = it1 ? gp1 : gp0;
    if (tid < 128 * NI) { const int t = tid & 127, d = t >> 6, p = t & 63, gi = d * 32 + (gp_1 >> 3); s1_lr = in.lam_re[gi * 64 + p]; s1_li = in.lam_im[gi * 64 + p]; s1_ldt = in.log_dt[gi]; }
    float p_lr[4 * NI], p_li[4 * NI], p_br[4 * NI], p_bi[4 * NI], p_cr[4 * NI], p_ci[4 * NI];
#pragma unroll
    for (int k = 0; k < 4 * NI; ++k) { const int g = ((k >> 2) ? gp1 : gp0) >> 3, el = tid + (k & 3) * NTHR;
        const int d = el >> 10, p = (el >> 4) & 63, h = el & 15, gi = d * 32 + g, h2 = (el >> 6) & 15, p2 = el & 63;
        p_lr[k] = in.lam_re[gi * 64 + p]; p_li[k] = in.lam_im[gi * 64 + p];
        p_br[k] = in.b_re[((size_t)gi * 64 + p) * 16 + h]; p_bi[k] = in.b_im[((size_t)gi * 64 + p) * 16 + h];
        p_cr[k] = in.c_re[((size_t)gi * 16 + h2) * 64 + p2]; p_ci[k] = in.c_im[((size_t)gi * 16 + h2) * 64 + p2]; }
    const float dsk00 = in.d_skip[(gp0 >> 3) * 16 + 2 * (gp0 & 7)], dsk01 = in.d_skip[(gp0 >> 3) * 16 + 2 * (gp0 & 7) + 1], dsk10 = in.d_skip[(gp1 >> 3) * 16 + 2 * (gp1 & 7)], dsk11 = in.d_skip[(gp1 >> 3) * 16 + 2 * (gp1 & 7) + 1];
    if (tid < 128 * NI) {
        LAS f32x2* apow = (LAS f32x2*)(lds + it1 * ISZ);
        const int t = tid & 127, d = t >> 6, p = t & 63, g = gp_1 >> 3;
        const float dt = expf(s1_ldt), mag = expf(s1_lr * dt), ar = mag * cosf(s1_li * dt), ai = mag * sinf(s1_li * dt);
        float zr = 1.f, zi = 0.f;
        for (int m = 0; m <= 16; ++m) { apow[(d * 17 + m) * 64 + p] = (f32x2){zr, zi}; const float nr = zr * ar - zi * ai; zi = zr * ai + zi * ar; zr = nr; }
        if ((gp_1 & 7) == 0) ((f32x2*)(ws + WS_AL))[(g * 2 + d) * 64 + p] = apow[(d * 17 + 16) * 64 + p];
    }
    __syncthreads();
#pragma unroll
    for (int k = 0; k < 4 * NI; ++k) { const int it = k >> 2, el = tid + (k & 3) * NTHR;
        LAS f32x2* apow = (LAS f32x2*)(lds + it * ISZ); LAS f32x2* bbar = (LAS f32x2*)(lds + it * ISZ + 17408); LAS f32x2* cc = (LAS f32x2*)(lds + it * ISZ + 17408 + 16384);
        const int d = el >> 10, p = (el >> 4) & 63, h = el & 15, h2 = (el >> 6) & 15, p2 = el & 63;
        const float lr = p_lr[k], li = p_li[k];
        const f32x2 a = apow[(d * 17 + 1) * 64 + p]; const float nr = a.x - 1.f, ni = a.y, den = 1.f / (lr * lr + li * li);
        const float qr = (nr * lr + ni * li) * den, qi = (ni * lr - nr * li) * den;
        bbar[(d * 64 + p) * 16 + h] = (f32x2){qr * p_br[k] - qi * p_bi[k], qr * p_bi[k] + qi * p_br[k]};
        cc[(d * 16 + h2) * 64 + p2] = (f32x2){p_cr[k], p_ci[k]};
    }
    __syncthreads();
#pragma unroll
    for (int it = 0; it < NI; ++it) {
        LAS f32x2* apow = (LAS f32x2*)(lds + it * ISZ); LAS f32x2* bbar = (LAS f32x2*)(lds + it * ISZ + 17408); LAS f32x2* cc = (LAS f32x2*)(lds + it * ISZ + 17408 + 16384); LAS float* Kt = (LAS float*)(lds + it * ISZ + 17408 + 32768);
        const int part = (it ? gp1 : gp0) & 7;
        const int pq = tid & 7, combo = tid >> 3, d = combo >> 5, hpl = (combo >> 4) & 1, h = combo & 15, hp = 2 * part + hpl; float kk[16];
#pragma unroll
        for (int m = 0; m < 16; ++m) kk[m] = 0.f;
#pragma unroll
        for (int pi = 0; pi < 8; ++pi) { const int p = pq * 8 + pi; const f32x2 c = cc[(d * 16 + hp) * 64 + p], b = bbar[(d * 64 + p) * 16 + h], a = apow[(d * 17 + 1) * 64 + p];
            float zr = c.x * b.x - c.y * b.y, zi = c.x * b.y + c.y * b.x;
#pragma unroll
            for (int m = 0; m < 16; ++m) { kk[m] += zr; const float nr = zr * a.x - zi * a.y; zi = zr * a.y + zi * a.x; zr = nr; } }
#pragma unroll
        for (int m = 0; m < 16; ++m) { float v = kk[m]; v += __shfl_xor(v, 1); v += __shfl_xor(v, 2); v += __shfl_xor(v, 4); if (pq == 0) Kt[((d * 16 + m) * 2 + hpl) * 16 + h] = v; }
    }
    __syncthreads();
#pragma unroll
    for (int k = 0; k < 4 * NI; ++k) { const int it = k >> 2, e = tid + (k & 3) * NTHR, gp = it ? gp1 : gp0, g = gp >> 3, part = gp & 7;
        LAS f32x2* apow = (LAS f32x2*)(lds + it * ISZ); LAS f32x2* cc = (LAS f32x2*)(lds + it * ISZ + 17408 + 16384); LAS float* Kt = (LAS float*)(lds + it * ISZ + 17408 + 32768);
        bf16_t* W5 = (bf16_t*)(ws + WS_WS5) + (size_t)g * 131072;
        const int rl = e >> 6, i = rl >> 1, hpl = rl & 1, hp = 2 * part + hpl, r = i * 16 + hp, c8 = (e & 63) * 8; float v[8];
        if (c8 < 256) { const int j = c8 >> 4, h0 = c8 & 15;
#pragma unroll
            for (int q = 0; q < 8; ++q) { const int h = h0 + q; float x;
                if (j < i) x = Kt[((0 * 16 + (i - j)) * 2 + hpl) * 16 + h]; else if (j > i) x = Kt[((1 * 16 + (j - i)) * 2 + hpl) * 16 + h];
                else { x = Kt[((0 * 16 + 0) * 2 + hpl) * 16 + h] + Kt[((1 * 16 + 0) * 2 + hpl) * 16 + h]; if (h == hp) x += it ? (hpl ? dsk11 : dsk10) : (hpl ? dsk01 : dsk00); }
                v[q] = x; }
        } else { const int s = c8 - 256, d = s >> 7, pt = (s >> 6) & 1, p0 = s & 63, m = d ? 16 - i : i + 1;
#pragma unroll
            for (int q = 0; q < 8; ++q) { const f32x2 c = cc[(d * 16 + hp) * 64 + p0 + q], a = apow[(d * 17 + m) * 64 + p0 + q];
                v[q] = pt ? -(c.x * a.y + c.y * a.x) : (c.x * a.x - c.y * a.y); }
        }
        u32x4 o; o.x = cvt_pk_bf16(v[0], v[1]); o.y = cvt_pk_bf16(v[2], v[3]); o.z = cvt_pk_bf16(v[4], v[5]); o.w = cvt_pk_bf16(v[6], v[7]);
        *(u32x4*)(W5 + (size_t)r * 512 + c8) = o;
    }
#pragma unroll
    for (int k = 0; k < 2 * NI; ++k) { const int it = k >> 1, e = tid + (k & 1) * NTHR, gp = it ? gp1 : gp0, g = gp >> 3, part = gp & 7;
        LAS f32x2* apow = (LAS f32x2*)(lds + it * ISZ); LAS f32x2* bbar = (LAS f32x2*)(lds + it * ISZ + 17408);
        bf16_t* MBt = (bf16_t*)(ws + WS_MB) + (size_t)g * 65536;
        const int s = part * 32 + (e >> 5), c8 = (e & 31) * 8, d = s >> 7, pt = (s >> 6) & 1, p = s & 63, j = c8 >> 4, h0 = c8 & 15, m = d ? j : 15 - j; float v[8];
        const f32x2 a = apow[(d * 17 + m) * 64 + p];
#pragma unroll
        for (int q = 0; q < 8; ++q) { const f32x2 b = bbar[(d * 64 + p) * 16 + h0 + q]; v[q] = pt ? (a.x * b.y + a.y * b.x) : (a.x * b.x - a.y * b.y); }
        u32x4 o; o.x = cvt_pk_bf16(v[0], v[1]); o.y = cvt_pk_bf16(v[2], v[3]); o.z = cvt_pk_bf16(v[4], v[5]); o.w = cvt_pk_bf16(v[6], v[7]);
        *(u32x4*)(MBt + (size_t)s * 256 + c8) = o;
    }
    __syncthreads();
}

__device__ __forceinline__ void p0_prologue(const In& in, unsigned char* ws, LAS unsigned char* lds, int G) {
    const int tid = threadIdx.x, lane = tid & 63, wave = __builtin_amdgcn_readfirstlane(tid >> 6);
    const int bx = blockIdx.x;
    const bool split = (G % 16) == 0;
    const bool roleA = split ? ((bx >> 3) & 1) != 0 : true, roleB = split ? !roleA : true;
    const int nR = split ? G / 2 : G, ir = split ? ((bx >> 4) * 8 + (bx & 7)) : bx;
    if (roleA) {
        for (int gp = ir; gp < NG * 8; gp += 2 * nR) { if (gp + nR < NG * 8) s5_tables<2>(in, ws, lds, gp, gp + nR); else s5_tables<1>(in, ws, lds, gp, gp); }
        const int gt = ir * NTHR + tid, NGT = nR * NTHR;
        LAS f32x2* trig = (LAS f32x2*)lds;
        if (tid < 128) { const float ang = (float)tid * (1.0f / 64.0f); trig[tid] = (f32x2){cospif(ang), sinpif(ang)}; }
        __syncthreads();
        for (int e = gt; e < 256 * 4 * 32; e += NGT) {
            const int c4 = e & 255, g4 = (e >> 8) & 3, c0 = (e >> 10) * 4;
            f32x4 ac[4], as[4];
#pragma unroll
            for (int q = 0; q < 4; ++q) { ac[q] = (f32x4){0.f, 0.f, 0.f, 0.f}; as[q] = (f32x4){0.f, 0.f, 0.f, 0.f}; }
            for (int j0 = 0; j0 < 128; j0 += 16) { f32x4 w[16];
#pragma unroll
                for (int jj = 0; jj < 16; ++jj) w[jj] = *(const f32x4*)(in.w_fnet + (size_t)(g4 * 128 + j0 + jj) * 1024 + 4 * c4);
#pragma unroll
                for (int jj = 0; jj < 16; ++jj) {
#pragma unroll
                    for (int q = 0; q < 4; ++q) { const f32x2 cs = trig[((j0 + jj) * (c0 + q)) & 127]; ac[q] += cs.x * w[jj]; as[q] += cs.y * w[jj]; } } }
            const float s = 1.0f / 512.0f;
#pragma unroll
            for (int k = 0; k < 4; ++k) { u32x2 oc, os;
                oc.x = cvt_pk_bf16(ac[0][k] * s, ac[1][k] * s); oc.y = cvt_pk_bf16(ac[2][k] * s, ac[3][k] * s);
                os.x = cvt_pk_bf16(as[0][k] * s, as[1][k] * s); os.y = cvt_pk_bf16(as[2][k] * s, as[3][k] * s);
                *(u32x2*)((bf16_t*)(ws + WS_WC) + (size_t)(4 * c4 + k) * 512 + g4 * 128 + c0) = oc;
                *(u32x2*)((bf16_t*)(ws + WS_WSN) + (size_t)(4 * c4 + k) * 512 + g4 * 128 + c0) = os; }
        }
        __syncthreads();
        LAS float* ctab = (LAS float*)(lds + 4096);
        for (int i = tid; i < 2048; i += NTHR) ctab[i] = cospif((float)i * (1.0f / 1024.0f));
        __syncthreads();
        for (int e = gt; e < 2 * 1024 * 128; e += NGT) {
            const int which = e >> 17, k = (e >> 7) & 1023, n0 = (e & 127) * 8, sh = which ? 1536 : 0; float v[8];
#pragma unroll
            for (int q = 0; q < 8; ++q) v[q] = ctab[(k * (n0 + q) + sh) & 2047];
            u32x4 o; o.x = cvt_pk_bf16(v[0], v[1]); o.y = cvt_pk_bf16(v[2], v[3]); o.z = cvt_pk_bf16(v[4], v[5]); o.w = cvt_pk_bf16(v[6], v[7]);
            *(u32x4*)((bf16_t*)(ws + WS_DM) + (size_t)which * 1024 * 1024 + (size_t)k * 1024 + n0) = o;
        }
        __syncthreads();
    }
    if (roleB) {
        const int gw = ir * NWAVES + wave, NGW = nR * NWAVES;
        const int gt = ir * NTHR + tid, NGT = nR * NTHR;
        {
            LAS float* scr = (LAS float*)(lds + wave * 8448);
            constexpr int I_IN = (1024 / 64) * (3072 / 32), I_PLE = (256 / 64) * (1024 / 32), I_GLU = (512 / 64) * (2048 / 32), I_OUT = (1024 / 64) * (1024 / 32), I_UP = (1024 / 64) * (4096 / 32), I_DOWN = (4096 / 64) * (1024 / 32), I_G = I_OUT;
            constexpr int NITEMS = I_IN + I_PLE + I_GLU + I_OUT + I_UP + I_DOWN + I_G;
            for (int it = gw; it < NITEMS; it += NGW) {
                int r = it;
                if (r < I_IN) { transpose_item(in.w_in, 1024, 3072, (bf16_t*)(ws + WS_WIN), in.g_mix, 0, scr, r, lane); continue; } r -= I_IN;
                if (r < I_PLE) { transpose_item(in.w_ple, 256, 1024, (bf16_t*)(ws + WS_WPLE), nullptr, 0, scr, r, lane); continue; } r -= I_PLE;
                if (r < I_GLU) { transpose_item(in.w_glu, 512, 2048, (bf16_t*)(ws + WS_WGLU), nullptr, 1, scr, r, lane); continue; } r -= I_GLU;
                if (r < I_OUT) { transpose_item(in.w_out, 1024, 1024, (bf16_t*)(ws + WS_WOUT), nullptr, 0, scr, r, lane); continue; } r -= I_OUT;
                if (r < I_UP) { transpose_item(in.w_up, 1024, 4096, (bf16_t*)(ws + WS_WUP), in.g_ffn, 0, scr, r, lane); continue; } r -= I_UP;
                if (r < I_DOWN) { transpose_item(in.w_down, 4096, 1024, (bf16_t*)(ws + WS_WDOWN), nullptr, 0, scr, r, lane); continue; } r -= I_DOWN;
                transpose_item(in.w_ple_gate, 1024, 1024, (bf16_t*)(ws + WS_WG), in.g_ple, 0, scr, r, lane);
            }
        }
        for (int c0 = gw * 4; c0 < T * DPLE / 1024; c0 += NGW * 4) {
            f32x4 v[4][4];
#pragma unroll
            for (int r = 0; r < 4; ++r) { const f32x4* pr = (const f32x4*)in.p + (size_t)(c0 + r) * 256 + lane;
#pragma unroll
                for (int j = 0; j < 4; ++j) v[r][j] = __builtin_nontemporal_load(pr + 64 * j); }
#pragma unroll
            for (int r = 0; r < 4; ++r) { u32x2* o = (u32x2*)(ws + WS_PB) + (size_t)(c0 + r) * 256 + lane;
#pragma unroll
                for (int j = 0; j < 4; ++j) o[64 * j] = pack4(v[r][j]); }
        }
        for (int m0 = gw * 4; m0 < T; m0 += NGW * 4) {
            f32x4 v[4][4]; float s[4];
#pragma unroll
            for (int r = 0; r < 4; ++r) { const f32x4* xr = (const f32x4*)(in.x + (size_t)(m0 + r) * D) + lane;
#pragma unroll
                for (int j = 0; j < 4; ++j) v[r][j] = __builtin_nontemporal_load(xr + 64 * j); }
#pragma unroll
            for (int r = 0; r < 4; ++r) { s[r] = 0.f;
#pragma unroll
                for (int j = 0; j < 4; ++j) s[r] += (v[r][j][0] * v[r][j][0] + v[r][j][1] * v[r][j][1]) + (v[r][j][2] * v[r][j][2] + v[r][j][3] * v[r][j][3]); }
#pragma unroll
            for (int r = 0; r < 4; ++r) { const float rms = sqrtf(wave_sum(s[r]) * (1.0f / D) + EPS), rstd = 1.0f / rms;
                if (lane == 0) ((float*)(ws + WS_INVR))[m0 + r] = rms;
                u32x2* o = (u32x2*)((bf16_t*)(ws + WS_XN) + (size_t)(m0 + r) * D) + lane;
#pragma unroll
                for (int j = 0; j < 4; ++j) o[64 * j] = pack4(v[r][j] * rstd); }
        }
    }
}

template <int KIND>
__device__ __forceinline__ void rstd_table(LAS unsigned char* lds, unsigned char* ws, int G, size_t ssp_off) {
    LAS float* rs = (LAS float*)(lds + RS_OFF); LAS int* r0s = (LAS int*)(lds + RS_OFF + 8192);
    Seg<KIND> S; S.ws = ws; S.G = G; S.c = blockIdx.x; S.only = -1;
    const int tid = threadIdx.x;
    if (tid < 8) { Unit u; r0s[tid] = S.next(tid, u) ? u.r0 : -1; }
    __syncthreads();
    for (int e = tid; e < 8 * 256; e += NTHR) { const int r0 = r0s[e >> 8]; if (r0 < 0) continue;
        const f32x4* p = (const f32x4*)((const float*)(ws + ssp_off) + (size_t)(r0 + (e & 255)) * 16);
        const f32x4 a = p[0], b = p[1], c = p[2], d = p[3];
        const float s = ((a[0] + a[1]) + (a[2] + a[3])) + ((b[0] + b[1]) + (b[2] + b[3])) + ((c[0] + c[1]) + (c[2] + c[3])) + ((d[0] + d[1]) + (d[2] + d[3]));
        rs[e] = 1.0f / sqrtf(s * (1.0f / D) + EPS); }
    __syncthreads();
}

struct Args { const float* in[22]; float* out; unsigned char* ws; int ph_lo, ph_hi, coop, pad; };
constexpr int N_PHASES = 9;

__global__ void __launch_bounds__(NTHR, 2) fwd_kernel(Args args) {
    extern __shared__ __attribute__((aligned(16))) unsigned char lds_raw[];
    LAS unsigned char* lds = (LAS unsigned char*)lds_raw;
    unsigned char* ws = args.ws;
    const int G = gridDim.x, tid = threadIdx.x, lane = tid & 63, wave = __builtin_amdgcn_readfirstlane(tid >> 6);
    In in; { const float* const* q = args.in; in.x = q[0]; in.p = q[1]; in.g_mix = q[2]; in.w_in = q[3]; in.lam_re = q[4]; in.lam_im = q[5]; in.log_dt = q[6]; in.b_re = q[7]; in.b_im = q[8]; in.c_re = q[9]; in.c_im = q[10];
        in.d_skip = q[11]; in.w_glu = q[12]; in.w_fnet = q[13]; in.w_out = q[14]; in.g_ffn = q[15]; in.w_up = q[16]; in.w_down = q[17]; in.g_ple = q[18]; in.w_ple_gate = q[19]; in.w_ple = q[20]; in.g_final = q[21]; }
    const int lo = args.ph_lo, hi = args.ph_hi;
#define IN_PH(k) (lo <= (k) && (k) < hi)
    if (args.coop == 2) cg::this_grid().sync();
    { volatile LAS unsigned* misc = (volatile LAS unsigned*)(lds + MISC_OFF); if (tid < 16) misc[tid] = 0u; }
    __syncthreads();
    XcdBarrier bar; bar.bar = (unsigned*)(ws + WS_CTL) + CW_BAR; bar.x = 0; bar.st = (volatile LAS unsigned*)(lds + MISC_OFF);
    if (args.coop) bar = xcd_barrier_post((unsigned*)(ws + WS_CTL) + CW_BAR, (volatile LAS unsigned*)(lds + MISC_OFF));
    const bool use_team = (G == 256) && args.coop;
    TeamBar tbar, gbar; { const int x_ = blockIdx.x & 7, k_ = blockIdx.x >> 3; tbar.cnt = (unsigned*)(ws + WS_CTL) + CW_TEAMC + (x_ * 8 + (k_ & 7)) * 64; tbar.target = 0u; tbar.same = false; tbar.n = 4u;
        gbar.cnt = (unsigned*)(ws + WS_CTL) + CW_GRPC + x_ * 64; gbar.target = 0u; gbar.same = false; gbar.n = 32u;
        if (use_team && tid == 0) ((unsigned*)(ws + WS_CTL))[CW_GRPX + x_ * 32 + k_] = 0x100u | xb_xcc_id();
        if (use_team && tid == 0) ((unsigned*)(ws + WS_CTL))[CW_TEAMX + (x_ * 8 + (k_ & 7)) * 4 + (k_ >> 3)] = 0x100u | xb_xcc_id(); }
#define SEAM(k) do { if (IN_PH(k) && IN_PH((k) + 1)) { if (use_team && ((k) == 5 || (k) == 6 || (k) == 7)) team_barrier(tbar); else if (use_team && (k) == 1) team_barrier(gbar); else xcd_barrier(bar);     \
        if ((k) == 0 && use_team) { const unsigned id_ = xb_ld((unsigned*)(ws + WS_CTL) + CW_GRPX + (blockIdx.x & 7) * 32 + (lane & 31)), id0_ = (unsigned)__builtin_amdgcn_readfirstlane((int)id_); \
            gbar.same = (id0_ >= 0x100u) && __all(id_ == id0_); } \
        if ((k) == 3 && use_team) { const unsigned* tx_ = (const unsigned*)(ws + WS_CTL) + CW_TEAMX + ((blockIdx.x & 7) * 8 + ((blockIdx.x >> 3) & 7)) * 4; \
            const unsigned a_ = xb_ld((unsigned*)tx_), b_ = xb_ld((unsigned*)tx_ + 1), c_ = xb_ld((unsigned*)tx_ + 2), d_ = xb_ld((unsigned*)tx_ + 3); tbar.same = (a_ >= 0x100u) && a_ == b_ && a_ == c_ && a_ == d_; } } } while (0)

#define PHASE_BODY_0 { p0_prologue(in, ws, lds, G); __syncthreads(); }
    if (IN_PH(0)) { PHASE_BODY_0 if ((PROBE_DUP >> 0) & 1) { PHASE_BODY_0 } }
    SEAM(0);
#define PHASE_BODY_1 { \
        { EpiP1Main E; E.ws = ws; run_segment<SG_P1MAIN>(lds, ws, G, E); } \
        { EpiP1Swap E; E.ws = ws; run_segment<SG_P1SWAP>(lds, ws, G, E); } \
        { EpiStore E; E.O = (bf16_t*)(ws + WS_PP); E.ldo = 1024; run_segment<SG_P1PP>(lds, ws, G, E); } \
    }
    if (IN_PH(1)) { PHASE_BODY_1 if ((PROBE_DUP >> 1) & 1) { PHASE_BODY_1 } }
    SEAM(1);
#define PHASE_BODY_2 { \
        { EpiScan E; E.ws = ws; E.ebuf = (LAS float*)lds; run_segment<SG_E>(lds, ws, G, E); } \
        { EpiDft E; E.ws = ws; run_segment<SG_DFT>(lds, ws, G, E); } \
        for (int o_ = (blockIdx.x * NWAVES + wave); o_ < NB * 512; o_ += G * NWAVES) {        \
            const int o = use_team ? (((int)blockIdx.x & 7) << 10) + (((int)blockIdx.x >> 3) << 3) + wave + ((o_ >> 11) << 8) : o_; \
            const bf16_t* er = (const bf16_t*)(ws + WS_UT) + (size_t)o * 1024 + lane * 16; \
            const u32x4 w0 = *(const u32x4*)er, w1 = *(const u32x4*)(er + 8); \
            const f32x4 x0 = unpack_lo(w0), x1 = unpack_hi(w0), x2 = unpack_lo(w1), x3 = unpack_hi(w1); \
            float s = ((x0[0] - x0[1]) + (x0[2] - x0[3])) + ((x1[0] - x1[1]) + (x1[2] - x1[3])) + ((x2[0] - x2[1]) + (x2[2] - x2[3])) + ((x3[0] - x3[1]) + (x3[2] - x3[3])); \
            s = wave_sum(s) + ((const float*)(ws + WS_U1024))[o]; \
            if (lane == 0) ((bf16_t*)(ws + WS_R))[((size_t)(o >> 9) * 2048 + 1024) * 512 + (o & 511)] = (bf16_t)(cvt_pk_bf16(s, 0.f) & 0xffffu); \
        } \
    }
    if (IN_PH(2)) { PHASE_BODY_2 if ((PROBE_DUP >> 2) & 1) { PHASE_BODY_2 } }
    SEAM(2);
#define PHASE_BODY_3 { \
        { EpiP3All E; E.ws = ws; E.Y = (bf16_t*)args.out; run_segment<SG_P3ALL>(lds, ws, G, E); } \
        \
        for (int e = blockIdx.x * NTHR + tid; e < NB * 1024 * 8; e += G * NTHR) { \
            const int part = e & 7, o = e >> 3, b = o >> 10, col = o & 1023; \
            const bf16_t* r = (const bf16_t*)(ws + WS_R) + ((size_t)b * 2048 + 1024) * 512 + part * 64; \
            const bf16_t* w = (const bf16_t*)(ws + WS_WC) + (size_t)col * 512 + part * 64; float s = 0.f; \
_Pragma("unroll") \
            for (int q = 0; q < 16; ++q) { const f32x4 a = unpack4(*(const u32x2*)(r + 4 * q)), c = unpack4(*(const u32x2*)(w + 4 * q)); s += (a[0] * c[0] + a[1] * c[1]) + (a[2] * c[2] + a[3] * c[3]); } \
            s += __shfl_xor(s, 1); s += __shfl_xor(s, 2); s += __shfl_xor(s, 4); \
            if (part == 0) ((bf16_t*)args.out)[((size_t)b * 2048 + 1024) * 1024 + col] = (bf16_t)(cvt_pk_bf16(s, 0.f) & 0xffffu); \
        } \
    }
    if (IN_PH(3)) { PHASE_BODY_3 if ((PROBE_DUP >> 3) & 1) { PHASE_BODY_3 } }
    SEAM(3);
#define PHASE_BODY_4 { EpiGluM E; E.ws = ws; E.Y = (const bf16_t*)args.out; run_segment<SG_GLU>(lds, ws, G, E); }
    if (IN_PH(4)) { PHASE_BODY_4 if ((PROBE_DUP >> 4) & 1) { PHASE_BODY_4 } }
    SEAM(4);
#define PHASE_BODY_5 { EpiRes<0> E; E.x = in.x; E.ws = ws; E.ss = 0.f; run_segment<SG_OUT>(lds, ws, G, E); }
    if (IN_PH(5)) { PHASE_BODY_5 if ((PROBE_DUP >> 5) & 1) { PHASE_BODY_5 } }
    SEAM(5);
#define PHASE_BODY_6 { EpiUp E; E.ws = ws; E.rs = (const LAS float*)(lds + RS_OFF); E.hlo = (bf16_t*)args.out; run_segment<SG_UP>(lds, ws, G, E, [&]() { rstd_table<SG_UP>(lds, ws, G, WS_SSP1); }); }
    if (IN_PH(6)) { PHASE_BODY_6 if ((PROBE_DUP >> 6) & 1) { PHASE_BODY_6 } }
    SEAM(6);
    if (IN_PH(7)) { EpiRes<1> E; E.x = nullptr; E.ws = ws; E.ss = 0.f; run_segment<SG_DOWN>(lds, ws, G, E, NoHook(), (const void*)args.out); }
    SEAM(7);
    if (IN_PH(8)) { EpiFinal E; E.ws = ws; E.out = args.out; E.rs = (const LAS float*)(lds + RS_OFF); E.gfin = in.g_final; run_segment<SG_GATE>(lds, ws, G, E, [&]() { rstd_table<SG_GATE>(lds, ws, G, WS_SSP2); }); }
#undef IN_PH
#undef SEAM
}


#if DBG_STOP >= 0
__device__ __forceinline__ float bf2f(bf16_t v) { return __uint_as_float(((unsigned)v) << 16); }
__global__ void dbg_dump(float* dst, const float* out, const unsigned char* ws, int k) {
    const size_t n = (size_t)T * D;
    for (size_t i = (size_t)blockIdx.x * blockDim.x + threadIdx.x; i < n; i += (size_t)gridDim.x * blockDim.x) {
        float v = 0.f;
        if (k == 0) { v = bf2f(((const bf16_t*)(ws + WS_XN))[i]) + 2.f * bf2f(((const bf16_t*)(ws + WS_WIN))[i % (3072 * 1024)]) + 3.f * bf2f(((const bf16_t*)(ws + WS_WS5))[i % (32 * 256 * 512)]) + 5.f * bf2f(((const bf16_t*)(ws + WS_MB))[i % (32 * 65536)])
                    + 7.f * bf2f(((const bf16_t*)(ws + WS_DM))[i % (2048 * 2048)]) + 11.f * bf2f(((const bf16_t*)(ws + WS_WC))[i % (1024 * 512)]) + 13.f * bf2f(((const bf16_t*)(ws + WS_WSN))[i % (1024 * 512)]) + 0.5f * bf2f(((const bf16_t*)(ws + WS_PB))[i % ((size_t)T * 256)])
                    + bf2f(((const bf16_t*)(ws + WS_WGLU))[i % (2048 * 512)]) + bf2f(((const bf16_t*)(ws + WS_WUP))[i % (4096 * 1024)]) + bf2f(((const bf16_t*)(ws + WS_WDOWN))[i % (4096 * 1024)]) + bf2f(((const bf16_t*)(ws + WS_WG))[i % (1024 * 1024)]) + bf2f(((const bf16_t*)(ws + WS_WOUT))[i % (1024 * 1024)]) + bf2f(((const bf16_t*)(ws + WS_WPLE))[i % (1024 * 256)]) + ((const float*)(ws + WS_AL))[i % 8192]; }
        if (k == 1) { v = bf2f(((const bf16_t*)(ws + WS_ZA))[i]) + 2.f * bf2f(((const bf16_t*)(ws + WS_ZB))[i]) + 3.f * bf2f(((const bf16_t*)(ws + WS_PP))[i]) + 5.f * bf2f(((const bf16_t*)(ws + WS_XS))[(i & ~511ull) + (i & 255)]) + 7.f * bf2f(((const bf16_t*)(ws + WS_UT))[i % ((size_t)T * 512)]); }
        if (k == 2) { v = bf2f(((const bf16_t*)(ws + WS_XS))[i]) + 3.f * bf2f(((const bf16_t*)(ws + WS_R))[i % ((size_t)T * 512)]); }
        if (k == 3) { v = bf2f(((const bf16_t*)out)[i]) + 3.f * bf2f(((const bf16_t*)(ws + WS_YS))[i % ((size_t)T * 512)]); }
        if (k == 4) { v = bf2f(((const bf16_t*)(ws + WS_MG))[i]); }
        dst[i] = v;
    }
}
#endif
extern "C" void kernel_launch(void* const* d_in, const int* in_sizes, int n_in, void* d_out, int out_size, void* d_ws, size_t ws_size, hipStream_t stream) {
    static int grid = 0;
    if (grid == 0) {
        if (n_in != 22 || in_sizes[0] != T * D || out_size != T * D || ws_size < WS_END) { fprintf(stderr, "kernel_launch: unexpected problem (n_in %d, in0 %d, out %d, ws %zu < %zu)\n", n_in, n_in > 0 ? in_sizes[0] : -1, out_size, ws_size, (size_t)WS_END); grid = -1; return; }
        int dev = 0, cus = 0, per_cu = 0;
        if (hipGetDevice(&dev) != hipSuccess || hipDeviceGetAttribute(&cus, hipDeviceAttributeMultiprocessorCount, dev) != hipSuccess) { grid = -1; return; }
        if (hipFuncSetAttribute((const void*)fwd_kernel, hipFuncAttributeMaxDynamicSharedMemorySize, LDS_BYTES) != hipSuccess) { fprintf(stderr, "kernel_launch: hipFuncSetAttribute failed\n"); grid = -1; return; }
        if (hipOccupancyMaxActiveBlocksPerMultiprocessor(&per_cu, (const void*)fwd_kernel, NTHR, LDS_BYTES) != hipSuccess || per_cu < 1) { fprintf(stderr, "kernel_launch: occupancy query says %d blocks per CU\n", per_cu); (void)hipGetLastError(); per_cu = 1; }
        grid = cus * (per_cu < 1 ? 1 : 1);
    }
    if (grid < 0) return;
    (void)hipMemsetAsync((char*)d_ws + WS_CTL, 0, CTL_BYTES, stream);
    Args a{};
    for (int i = 0; i < 22; ++i) a.in[i] = (const float*)d_in[i];
    a.out = (float*)d_out; a.ws = (unsigned char*)d_ws;
#if N_LAUNCH_MODE
#if DBG_STOP >= 0
    for (int ph = 0; ph <= DBG_STOP; ++ph) { a.ph_lo = ph; a.ph_hi = ph + 1; a.coop = 0; hipLaunchKernelGGL(fwd_kernel, dim3(grid), dim3(NTHR), LDS_BYTES, stream, a); }
    if (DBG_STOP == 3) { hipLaunchKernelGGL(dbg_dump, dim3(2048), dim3(256), 0, stream, (float*)((char*)d_ws + WS_PP), (const float*)d_out, (const unsigned char*)d_ws, (int)DBG_STOP);
        (void)hipMemcpyAsync(d_out, (char*)d_ws + WS_PP, (size_t)T * D * 4, hipMemcpyDeviceToDevice, stream); }
    else if (DBG_STOP <= 4) hipLaunchKernelGGL(dbg_dump, dim3(2048), dim3(256), 0, stream, (float*)d_out, (const float*)d_out, (const unsigned char*)d_ws, (int)DBG_STOP);
#else
    for (int ph = 0; ph < N_PHASES; ++ph) { a.ph_lo = ph; a.ph_hi = ph + 1; a.coop = 0; hipLaunchKernelGGL(fwd_kernel, dim3(grid), dim3(NTHR), LDS_BYTES, stream, a); }
#endif
#else
    a.ph_lo = 0; a.ph_hi = N_PHASES; a.coop = 1;
    void* kargs[] = {&a};
    hipError_t e = hipLaunchCooperativeKernel((const void*)fwd_kernel, dim3(grid), dim3(NTHR), kargs, LDS_BYTES, stream);
    if (e != hipSuccess) fprintf(stderr, "kernel_launch: cooperative launch failed: %s (grid %d)\n", hipGetErrorString(e), grid);
#endif
}
```

```cpp
#include <hip/hip_runtime.h>
#include <hip/hip_cooperative_groups.h>
#include <cstdio>
#include <cstdint>
#include <type_traits>
namespace cg = cooperative_groups;

#ifndef FAST_MASK
#define FAST_MASK 0x3FFF
#endif
#ifndef N_LAUNCH_MODE
#define N_LAUNCH_MODE 0
#endif

#ifndef PROBE_DUP
#define PROBE_DUP 0
#endif
#ifndef DBG_STOP
#define DBG_STOP -1
#endif
#define LAS __attribute__((address_space(3)))
typedef unsigned short bf16_t;
typedef short bf16x8 __attribute__((ext_vector_type(8)));
typedef float f32x4 __attribute__((ext_vector_type(4)));
typedef float f32x2 __attribute__((ext_vector_type(2)));
typedef unsigned u32x2 __attribute__((ext_vector_type(2)));
typedef unsigned u32x4 __attribute__((ext_vector_type(4)));

constexpr int T = 32768, D = 1024, SEQ = 2048, NB = 16, DFF = 4096, DPLE = 256;
constexpr int NG = 32;
constexpr float EPS = 1e-6f;
constexpr int NWAVES = 8, NTHR = 512;

constexpr size_t MiB = 1u << 20;
constexpr size_t WS_CTL = 0, CTL_BYTES = 1 * MiB;
constexpr size_t CTL_SS3 = 256 * 1024;
constexpr size_t CTL_CNT = 512 * 1024;
constexpr size_t WS_WIN = 1 * MiB;
constexpr size_t WS_WPLE = 7 * MiB;
constexpr size_t WS_MB = 8 * MiB;
constexpr size_t WS_WS5 = 12 * MiB;
constexpr size_t WS_DM = 20 * MiB;
constexpr size_t WS_WC = 28 * MiB;
constexpr size_t WS_WSN = 29 * MiB;
constexpr size_t WS_WGLU = 30 * MiB;
constexpr size_t WS_WOUT = 32 * MiB;
constexpr size_t WS_WUP = 34 * MiB;
constexpr size_t WS_WDOWN = 42 * MiB;
constexpr size_t WS_WG = 50 * MiB;
constexpr size_t WS_AL = 52 * MiB;
constexpr size_t WS_U1024 = 52 * MiB + 65536;
constexpr size_t WS_INVR = 52 * MiB + 131072;
constexpr size_t WS_SSP1 = 53 * MiB;
constexpr size_t WS_SSP2 = 55 * MiB;
constexpr size_t WS_PP = 60 * MiB;
constexpr size_t WS_XB = 124 * MiB;
constexpr size_t WS_Z = 188 * MiB;
constexpr size_t WS_XN = WS_Z;
constexpr size_t WS_XS = WS_Z + 64 * MiB;
constexpr size_t WS_UT = WS_Z + 128 * MiB;
constexpr size_t WS_ZA = WS_Z + 160 * MiB;
constexpr size_t WS_ZB = WS_Z + 224 * MiB;
constexpr size_t WS_PB = WS_Z + 288 * MiB;
constexpr size_t WS_R = WS_Z + 288 * MiB;
constexpr size_t WS_YS = WS_Z + 128 * MiB;
constexpr size_t WS_MG = WS_Z + 64 * MiB;
constexpr size_t WS_HHI = WS_Z + 128 * MiB;
constexpr size_t WS_END = WS_Z + 320 * MiB;

constexpr int RING_BYTES = 131072;
constexpr int RS_OFF = 135168;
constexpr int MISC_OFF = 143616;
constexpr int LDS_BYTES = 147456;

typedef __bf16 bf16x2_t __attribute__((ext_vector_type(2)));
__device__ __forceinline__ unsigned cvt_pk_bf16(float lo, float hi) { const f32x2 v = {lo, hi}; const bf16x2_t r = __builtin_convertvector(v, bf16x2_t); return __builtin_bit_cast(unsigned, r); }
__device__ __forceinline__ u32x2 pack4(f32x4 v) { u32x2 w; w.x = cvt_pk_bf16(v[0], v[1]); w.y = cvt_pk_bf16(v[2], v[3]); return w; }
__device__ __forceinline__ f32x4 unpack4(u32x2 w) { f32x4 v; v[0] = __uint_as_float(w.x << 16); v[1] = __uint_as_float(w.x & 0xffff0000u); v[2] = __uint_as_float(w.y << 16); v[3] = __uint_as_float(w.y & 0xffff0000u); return v; }
__device__ __forceinline__ u32x4 pack8(f32x4 lo, f32x4 hi) { u32x4 w; w.x = cvt_pk_bf16(lo[0], lo[1]); w.y = cvt_pk_bf16(lo[2], lo[3]); w.z = cvt_pk_bf16(hi[0], hi[1]); w.w = cvt_pk_bf16(hi[2], hi[3]); return w; }
__device__ __forceinline__ f32x4 unpack_lo(u32x4 w) { u32x2 t; t.x = w.x; t.y = w.y; return unpack4(t); }
__device__ __forceinline__ f32x4 unpack_hi(u32x4 w) { u32x2 t; t.x = w.z; t.y = w.w; return unpack4(t); }
__device__ __forceinline__ unsigned q8x4(f32x4 s) {
    return (unsigned)(s[0] * 255.f + 0.5f) | ((unsigned)(s[1] * 255.f + 0.5f) << 8) | ((unsigned)(s[2] * 255.f + 0.5f) << 16) | ((unsigned)(s[3] * 255.f + 0.5f) << 24); }
__device__ __forceinline__ f32x4 dq8x4(unsigned w) { f32x4 r; r[0] = (float)(w & 255u); r[1] = (float)((w >> 8) & 255u); r[2] = (float)((w >> 16) & 255u); r[3] = (float)(w >> 24); return r * (1.0f / 255.f); }
__device__ __forceinline__ float sigmoidf_(float x) { return __builtin_amdgcn_rcpf(1.0f + __builtin_amdgcn_exp2f(-1.4426950409f * x)); }
__device__ __forceinline__ f32x4 sigmoid4(f32x4 v) { f32x4 r; r[0] = sigmoidf_(v[0]); r[1] = sigmoidf_(v[1]); r[2] = sigmoidf_(v[2]); r[3] = sigmoidf_(v[3]); return r; }
__device__ __forceinline__ float gelu_tanh(float x) { return x * sigmoidf_(1.5957691216f * (x + 0.044715f * x * x * x)); }
__device__ __forceinline__ float wave_sum(float v) {
#pragma unroll
    for (int o = 1; o < 64; o <<= 1) v += __shfl_xor(v, o);
    return v;
}
#define LDS_WAIT() asm volatile("s_waitcnt lgkmcnt(0)" ::: "memory")
#define QT_ROW ((int)(threadIdx.x & 63) >> 2)
#define QT_COL ((int)(threadIdx.x & 3) * 8)
__device__ __forceinline__ u32x4 qtr(u32x4 v) { const int l = threadIdx.x & 63, s = ((l & 3) << 4) | (l >> 2); u32x4 r;
    r.x = (unsigned)__shfl((int)v.x, s); r.y = (unsigned)__shfl((int)v.y, s); r.z = (unsigned)__shfl((int)v.z, s); r.w = (unsigned)__shfl((int)v.w, s); return r; }
__device__ __forceinline__ void qst(float* p, f32x4 v) { u32x4 w; w.x = __float_as_uint(v[0]); w.y = __float_as_uint(v[1]); w.z = __float_as_uint(v[2]); w.w = __float_as_uint(v[3]); *(u32x4*)p = qtr(w); }
__device__ __forceinline__ u32x2 qtr(u32x2 v) { const int l = threadIdx.x & 63, s = ((l & 3) << 4) | (l >> 2); u32x2 r; r.x = (unsigned)__shfl((int)v.x, s); r.y = (unsigned)__shfl((int)v.y, s); return r; }


#define XB_TMO      128
#define XB_XCNT(j)  (256  + 64 * (j))
#define XB_XSUB(j)  (1280 + 64 * (j))
#define XB_XGEN(j)  (2304 + 64 * (j))
#define XB_TOP      3328
#define XB_TOPGEN   3392
#define XCD_BAR_WORDS 3456
#define XB_SPIN_CAP (1u << 18)
constexpr int CW_BAR = 4096;
__device__ __forceinline__ unsigned xb_ld(unsigned* p)              { return __hip_atomic_load(p, __ATOMIC_RELAXED, __HIP_MEMORY_SCOPE_AGENT); }
__device__ __forceinline__ unsigned xb_add(unsigned* p, unsigned v) { return __hip_atomic_fetch_add(p, v, __ATOMIC_RELAXED, __HIP_MEMORY_SCOPE_AGENT); }
__device__ __forceinline__ unsigned xb_xcc_id() { return (unsigned)__builtin_amdgcn_s_getreg((3 << 11) | 20) & 0xFu; }
#define XB_SPIN(cond, bar) do { unsigned _sp = 0; while (cond) { __builtin_amdgcn_s_sleep(1); \
    if ((++_sp & 255u) == 0u) { if (xb_ld(&(bar)[XB_TMO])) break; if (_sp > XB_SPIN_CAP) { atomicAdd(&(bar)[XB_TMO], 1u); break; } } } } while (0)
struct XcdBarrier { unsigned* bar; unsigned x; volatile LAS unsigned* st; };
__device__ __forceinline__ XcdBarrier xcd_barrier_post(unsigned* bar, volatile LAS unsigned* st) {
    XcdBarrier b; b.bar = bar; b.x = xb_xcc_id(); b.st = st;
    if (threadIdx.x == 0) (void)xb_add(&bar[XB_XCNT(b.x)], 1u);
    return b;
}
__device__ __forceinline__ void xcd_barrier_complete(unsigned* bar, unsigned x, unsigned& nloc, unsigned& nx) {
    const unsigned G = gridDim.x * gridDim.y * gridDim.z;
    unsigned sum, cnt, mine, sp = 0u;
    for (;;) {
        sum = 0u; cnt = 0u; mine = 0u;
#pragma unroll
        for (unsigned j = 0; j < 16; ++j) { const unsigned c = xb_ld(&bar[XB_XCNT(j)]); sum += c; cnt += (c > 0u) ? 1u : 0u; mine = (j == x) ? c : mine; }
        if (sum == G) break;
        __builtin_amdgcn_s_sleep(1);
        if ((++sp & 255u) == 0u) { if (xb_ld(&bar[XB_TMO])) break; if (sp > XB_SPIN_CAP) { atomicAdd(&bar[XB_TMO], 1u); break; } }
    }
    nloc = mine > 0u ? mine : 1u; nx = cnt > 0u ? cnt : 1u;
}
__device__ __forceinline__ void xcd_barrier(const XcdBarrier& b) {
    asm volatile("s_waitcnt vmcnt(0)" ::: "memory");
    __syncthreads();
    if (threadIdx.x == 0) {
        unsigned* bar = b.bar;
        __builtin_amdgcn_s_waitcnt(0);
        unsigned nloc = b.st[0], nx = b.st[1];
        if (nloc == 0u) { xcd_barrier_complete(bar, b.x, nloc, nx); b.st[0] = nloc; b.st[1] = nx; }
        const unsigned old = xb_add(&bar[XB_XSUB(b.x)], 1u);
        const unsigned gen = old / nloc;
        if (old + 1u == (gen + 1u) * nloc) {
            __builtin_amdgcn_fence(__ATOMIC_RELEASE, "agent");
            asm volatile("s_waitcnt vmcnt(0)" ::: "memory");
            const unsigned og = xb_add(&bar[XB_TOP], 1u);
            const unsigned tg = og / nx;
            if (og + 1u == (tg + 1u) * nx) xb_add(&bar[XB_TOPGEN], 1u);
            else XB_SPIN(xb_ld(&bar[XB_TOPGEN]) == tg, bar);
            __builtin_amdgcn_fence(__ATOMIC_ACQUIRE, "agent");
            xb_add(&bar[XB_XGEN(b.x)], 1u);
            asm volatile("s_waitcnt vmcnt(0)" ::: "memory");
        } else {
            XB_SPIN(xb_ld(&bar[XB_XGEN(b.x)]) == gen, bar);
            __builtin_amdgcn_fence(__ATOMIC_ACQUIRE, "agent");
            asm volatile("s_waitcnt vmcnt(0)" ::: "memory");
        }
    }
    __syncthreads();
}

constexpr int CW_TEAMX = 12288, CW_TEAMC = 16384;
struct TeamBar { unsigned* cnt; unsigned target; bool same; };
__device__ __forceinline__ void team_barrier(TeamBar& tb) {
    asm volatile("s_waitcnt vmcnt(0)" ::: "memory");
    __syncthreads();
    tb.target += 4u;
    if (threadIdx.x == 0) {
        __builtin_amdgcn_s_waitcnt(0);
        if (!tb.same) { __builtin_amdgcn_fence(__ATOMIC_RELEASE, "agent"); asm volatile("s_waitcnt vmcnt(0)" ::: "memory"); }
        xb_add(tb.cnt, 1u);
        { unsigned sp = 0; while (xb_ld(tb.cnt) < tb.target) { __builtin_amdgcn_s_sleep(1); if (++sp > (1u << 22)) break; } }
        __builtin_amdgcn_fence(__ATOMIC_ACQUIRE, "agent");
        asm volatile("s_waitcnt vmcnt(0)" ::: "memory");
    }
    __syncthreads();
}

struct Unit { const bf16_t* A; const bf16_t* B; const bf16_t* A2; int r0, c0, slot, aux, sub; };
constexpr int NXCD = 8, WGM = 8;
__device__ __forceinline__ bool unit_order(int L, int nM, int nN, int& pm, int& pn) {
    const int nwg = nM * nN; if (L >= nwg) return false;
    int wgid = L; { const int q = nwg / NXCD, r = nwg % NXCD, xcd = wgid % NXCD, off = wgid / NXCD; wgid = (xcd < r ? xcd * (q + 1) : r * (q + 1) + (xcd - r) * q) + off; }
    const int nig = WGM * nN, gid = wgid / nig, fm = gid * WGM, gsz = (nM - fm) < WGM ? (nM - fm) : WGM;
    pm = fm + ((wgid % nig) % gsz); pn = (wgid % nig) / gsz; return true;
}
enum SegKind { SG_P1MAIN = 0, SG_P1SWAP, SG_P1PP, SG_E, SG_DFT, SG_Y, SG_FNET, SG_GLU, SG_OUT, SG_UP, SG_DOWN, SG_GATE, SG_P1ALL  , SG_P3ALL  , SG_N };
struct Ptrs {
    const float* x; float* out; unsigned char* ws;
};
template <int KIND> struct Seg {
    unsigned char* ws; int G, c, only;
    const void* ext = nullptr;
    static constexpr bool SPLITA = (KIND == SG_DOWN);
    __device__ __forceinline__ static constexpr int nM() { return (KIND == SG_P1SWAP) ? 2 : (KIND == SG_E || KIND == SG_Y) ? 256 : 128; }
    __device__ __forceinline__ static constexpr int nN() { return KIND == SG_P1MAIN ? 10 : KIND == SG_P1SWAP ? 128 : KIND == SG_P1PP ? 4 : (KIND == SG_E || KIND == SG_Y) ? 1 : KIND == SG_DFT ? 2 : KIND == SG_FNET ? 4 : KIND == SG_GLU ? 8 : KIND == SG_UP ? 16 : 4; }
    static constexpr bool CUSTOMB = (KIND == SG_P1SWAP);
    static constexpr bool CUSTOMA = (KIND == SG_GLU);
    __device__ __forceinline__ static constexpr int lda() { return (KIND == SG_P1PP) ? 256 : (KIND == SG_E || KIND == SG_Y || KIND == SG_FNET || KIND == SG_GLU || KIND == SG_P3ALL) ? 512 : KIND == SG_DOWN ? 2048 : 1024; }
    __device__ __forceinline__ static constexpr int ldb() { return (KIND == SG_P1PP || KIND == SG_E) ? 256 : (KIND == SG_Y || KIND == SG_FNET || KIND == SG_GLU || KIND == SG_P3ALL) ? 512 : KIND == SG_DOWN ? 4096 : 1024; }
    __device__ __forceinline__ static constexpr int K() { return (KIND == SG_P1PP || KIND == SG_E) ? 256 : (KIND == SG_Y || KIND == SG_FNET || KIND == SG_GLU || KIND == SG_P3ALL) ? 512 : KIND == SG_DOWN ? 4096 : 1024; }
    __device__ __forceinline__ static constexpr int total() { return KIND == SG_P1ALL ? 1280 + 256 : KIND == SG_P3ALL ? 256 + 512 : nM() * nN(); }
    __device__ __forceinline__ int count() const { const int n = total(); return (n - c + G - 1) / G; }
    __device__ __forceinline__ bool next(int i, Unit& u) const {
        if (only >= 0) { if (i != 0) return false; i = only; }
        u.slot = i; u.aux = 0; u.sub = 0;
        if constexpr (KIND == SG_P1ALL) {
            const int L = i * G + c; int pm, pn; if (L >= total()) return false;
            if (L < 1280) { unit_order(L, 128, 10, pm, pn); u.A = (const bf16_t*)(ws + WS_XN) + (size_t)pm * 256 * 1024; u.B = (const bf16_t*)(ws + WS_WIN) + (size_t)(pn < 2 ? pn : pn + 2) * 256 * 1024; u.r0 = pm * 256; u.c0 = pn * 256; }
            else { unit_order(L - 1280, 2, 128, pm, pn); u.sub = 1; u.A = (const bf16_t*)(ws + WS_WIN) + (size_t)(512 + pm * 256) * 1024; u.B = (const bf16_t*)(ws + WS_XN) + (size_t)pn * 256 * 1024; u.r0 = pm * 256; u.c0 = pn * 256; }
            return true;
        }
        if constexpr (KIND == SG_P3ALL) {
            const int L = i * G + c; int pm, pn; if (L >= total()) return false;
            if (L < 256) { unit_order(L, 256, 1, pm, pn); const int g = pm >> 3, rt = pm & 7; u.A = (const bf16_t*)(ws + WS_XS) + ((size_t)g * 2048 + rt * 256) * 512; u.B = (const bf16_t*)(ws + WS_WS5) + (size_t)g * 131072; u.r0 = rt * 256; u.c0 = 0; u.aux = g; }
            else { unit_order(L - 256, 128, 4, pm, pn); u.sub = 1; u.A = (const bf16_t*)(ws + WS_R) + (size_t)pm * 256 * 512; u.B = (const bf16_t*)(ws + ((pm & 7) < 4 ? WS_WC : WS_WSN)) + (size_t)pn * 256 * 512; u.r0 = pm * 256; u.c0 = pn * 256; }
            return true;
        }
        int pm, pn; if (!unit_order(i * G + c, nM(), nN(), pm, pn)) return false;
        if constexpr (KIND == SG_P1MAIN) { u.A = (const bf16_t*)(ws + WS_XN) + (size_t)pm * 256 * 1024; u.B = (const bf16_t*)(ws + WS_WIN) + (size_t)(pn < 2 ? pn : pn + 2) * 256 * 1024; u.r0 = pm * 256; u.c0 = pn * 256; }
        if constexpr (KIND == SG_P1SWAP) { u.A = (const bf16_t*)(ws + WS_WIN) + (size_t)(512 + pm * 256) * 1024; u.B = (const bf16_t*)(ws + WS_XN) + (size_t)(pn >> 3) * 2048 * 1024; u.r0 = pm * 256; u.c0 = (pn & 7) * 128; u.aux = pn >> 3; }
        if constexpr (KIND == SG_P1PP) { u.A = (const bf16_t*)(ws + WS_PB) + (size_t)pm * 256 * 256; u.B = (const bf16_t*)(ws + WS_WPLE) + (size_t)pn * 256 * 256; u.r0 = pm * 256; u.c0 = pn * 256; }
        if constexpr (KIND == SG_E) { const int g = pm >> 3, rt = pm & 7; u.A = (const bf16_t*)(ws + WS_XS) + ((size_t)g * 2048 + rt * 256) * 512; u.B = (const bf16_t*)(ws + WS_MB) + (size_t)g * 65536; u.r0 = rt * 256; u.c0 = 0; u.aux = g; }
        if constexpr (KIND == SG_DFT) { const int b = pm >> 3, rt = pm & 7; u.A = (const bf16_t*)(ws + WS_DM) + (size_t)rt * 256 * 1024;
            u.B = (const bf16_t*)(ws + WS_UT) + ((size_t)(rt < 4 ? 0 : 16) * 512 + (size_t)b * 512 + pn * 256) * 1024; u.r0 = pm * 256; u.c0 = pn * 256; u.aux = b; }
        if constexpr (KIND == SG_Y) { const int g = pm >> 3, rt = pm & 7; u.A = (const bf16_t*)(ws + WS_XS) + ((size_t)g * 2048 + rt * 256) * 512; u.B = (const bf16_t*)(ws + WS_WS5) + (size_t)g * 131072; u.r0 = rt * 256; u.c0 = 0; u.aux = g; }
        if constexpr (KIND == SG_FNET) { u.A = (const bf16_t*)(ws + WS_R) + (size_t)pm * 256 * 512; u.B = (const bf16_t*)(ws + ((pm & 7) < 4 ? WS_WC : WS_WSN)) + (size_t)pn * 256 * 512; u.r0 = pm * 256; u.c0 = pn * 256; }
        if constexpr (KIND == SG_GLU) { const int b = pm >> 3, jt = pm & 7;
            u.A = (const bf16_t*)(ws + WS_YS) + ((size_t)b * 2048 + jt * 128) * 512; u.A2 = (const bf16_t*)(ws + WS_YS) + ((size_t)b * 2048 + 2048 - jt * 128 - 127) * 512;
            u.B = (const bf16_t*)(ws + WS_WGLU) + (size_t)pn * 256 * 512; u.r0 = b * 2048; u.c0 = pn * 128; u.aux = jt; u.sub = (jt == 0); }
        if constexpr (KIND == SG_OUT) { u.A = (const bf16_t*)(ws + WS_MG) + (size_t)pm * 256 * 1024; u.B = (const bf16_t*)(ws + WS_WOUT) + (size_t)pn * 256 * 1024; u.r0 = pm * 256; u.c0 = pn * 256; }
        if constexpr (KIND == SG_UP) { u.A = (const bf16_t*)(ws + WS_XB) + (size_t)pm * 256 * 1024; u.B = (const bf16_t*)(ws + WS_WUP) + (size_t)pn * 256 * 1024; u.r0 = pm * 256; u.c0 = pn * 256; }
        if constexpr (KIND == SG_DOWN) { u.A = (const bf16_t*)ext + (size_t)pm * 256 * 2048; u.A2 = (const bf16_t*)(ws + WS_HHI) + (size_t)pm * 256 * 2048; u.B = (const bf16_t*)(ws + WS_WDOWN) + (size_t)pn * 256 * 4096; u.r0 = pm * 256; u.c0 = pn * 256; }
        if constexpr (KIND == SG_GATE) { u.A = (const bf16_t*)(ws + WS_XB) + (size_t)pm * 256 * 1024; u.B = (const bf16_t*)(ws + WS_WG) + (size_t)pn * 256 * 1024; u.r0 = pm * 256; u.c0 = pn * 256; }
        return true;
    }
};

struct NoPre {};
struct EpiBase {
    static constexpr bool AFTER_DRAIN = false, WHOLE_TILE = false;
    static constexpr int MB = 4;
    typedef NoPre Pre;
    __device__ __forceinline__ void load(const Unit&, int, int, NoPre&) {}
    __device__ __forceinline__ void row_begin() {}
    __device__ __forceinline__ void row_end(const Unit&, int, int, int) {}
    __device__ __forceinline__ void half_done(const Unit&, int) {}
};
struct EpiStore : EpiBase {
    bf16_t* O; int ldo;
    __device__ __forceinline__ void pair8(const Unit& u, int lrow, int colq, f32x4 a0, f32x4 a1, f32x4 b0, f32x4 b1, const Pre&) {
        bf16_t* p = O + (size_t)(u.r0 + lrow - (int)(threadIdx.x & 15) + QT_ROW) * ldo + u.c0 + (colq & ~31) + QT_COL;
        *(u32x4*)p = qtr(pack8(a0, a1)); *(u32x4*)(p + 32) = qtr(pack8(b0, b1));
    }
};
struct EpiP1Main : EpiBase {
    unsigned char* ws;
    __device__ __forceinline__ void pair8(const Unit& u, int lrow, int colq, f32x4 a0, f32x4 a1, f32x4 b0, f32x4 b1, const Pre&) {
        const int t = u.r0 + lrow;
        if (u.c0 < 512) {
            const int b = t >> 11, pos = t & 2047, c = pos >> 4, j = pos & 15;
#pragma unroll
            for (int bj = 0; bj < 2; ++bj) { const int vcol = u.c0 + colq + bj * 32, g = vcol >> 4, h = vcol & 15;
                bf16_t* p = (bf16_t*)(ws + WS_XS) + ((size_t)g * 2048 + b * 128 + c) * 512 + j * 16 + h; *(u32x4*)p = bj ? pack8(b0, b1) : pack8(a0, a1); }
        } else {
            const int zc = u.c0 - 512; unsigned char* base = ws + (zc < 1024 ? WS_ZA : WS_ZB) + (size_t)(t - (int)(threadIdx.x & 15) + QT_ROW) * 1024 + (zc & 1023) + (colq & ~31) + QT_COL;
            u32x2 wa, wb; wa.x = q8x4(sigmoid4(a0)); wa.y = q8x4(sigmoid4(a1)); wb.x = q8x4(sigmoid4(b0)); wb.y = q8x4(sigmoid4(b1));
            *(u32x2*)base = qtr(wa); *(u32x2*)(base + 32) = qtr(wb);
        }
    }
};
struct EpiP1Swap : EpiBase {
    unsigned char* ws;
    __device__ __forceinline__ void pair8(const Unit& u, int lrow, int colq, f32x4 a0, f32x4 a1, f32x4 b0, f32x4 b1, const Pre&) {
        const int ch = u.r0 + lrow, n0 = u.c0 + (colq >> 6) * 32 + (colq & 63);
        f32x4 e0 = a0 + b0, e1 = a1 + b1, o0 = a0 - b0, o1 = a1 - b1;
        if (n0 == 0) { e0[0] = a0[0]; o0[0] = 0.f; ((float*)(ws + WS_U1024))[u.aux * 512 + ch] = b0[0]; }
        const size_t off = ((size_t)u.aux * 512 + ch - (int)(threadIdx.x & 15) + QT_ROW) * 1024 + u.c0 + (colq >> 6) * 32 + QT_COL;
        *(u32x4*)((bf16_t*)(ws + WS_UT) + off) = qtr(pack8(e0, e1));
        *(u32x4*)((bf16_t*)(ws + WS_UT) + (size_t)16 * 512 * 1024 + off) = qtr(pack8(o0, o1));
    }
};
struct DftPre { f32x4 c[4]; };
struct EpiDft : EpiBase {
    typedef DftPre Pre; static constexpr int MB = 2;
    unsigned char* ws;
    __device__ __forceinline__ void load(const Unit& u, int lrow, int colq, DftPre& q) {
        const float* p = (const float*)(ws + WS_U1024) + u.aux * 512 + u.c0 + colq;
        q.c[0] = *(const f32x4*)p; q.c[1] = *(const f32x4*)(p + 4); q.c[2] = *(const f32x4*)(p + 32); q.c[3] = *(const f32x4*)(p + 36);
    }
    __device__ __forceinline__ void pair8(const Unit& u, int lrow, int colq, f32x4 a0, f32x4 a1, f32x4 b0, f32x4 b1, const DftPre& q) {
        const int row = u.r0 + lrow, pos = row & 2047;
        if (pos < 1024) { const float sg = (pos & 1) ? -1.f : 1.f; a0 += sg * q.c[0]; a1 += sg * q.c[1]; b0 += sg * q.c[2]; b1 += sg * q.c[3]; }
        const u32x4 A = qtr(pack8(a0, a1)), B = qtr(pack8(b0, b1)); const int row2 = row - (int)(threadIdx.x & 15) + QT_ROW; if ((row2 & 2047) == 1024) return;
        bf16_t* p = (bf16_t*)(ws + WS_R) + (size_t)row2 * 512 + u.c0 + (colq & ~31) + QT_COL; *(u32x4*)p = A; *(u32x4*)(p + 32) = B;
    }
};
struct EpiScan : EpiBase {
    static constexpr bool AFTER_DRAIN = true;
    unsigned char* ws; LAS float* ebuf;
    __device__ __forceinline__ void pair8(const Unit&, int lrow, int colq, f32x4 a0, f32x4 a1, f32x4 b0, f32x4 b1, const Pre&) {
        LAS bf16_t* p = (LAS bf16_t*)ebuf + lrow * 264 + colq; *(LAS u32x4*)p = pack8(a0, a1); *(LAS u32x4*)(p + 32) = pack8(b0, b1);
    }
    __device__ __forceinline__ void half_done(const Unit& u, int ai) {
        if (ai == 0) return;
        LDS_WAIT(); __syncthreads();
        const int tid = threadIdx.x;
        if (tid < 256) {
            const int sq = tid >> 7, dir = (tid >> 6) & 1, p = tid & 63, g = u.aux;
            const f32x2 aL = ((const f32x2*)(ws + WS_AL))[(g * 2 + dir) * 64 + p];
            const int seq = (u.r0 >> 7) + sq;
            bf16_t* xrow = (bf16_t*)(ws + WS_XS) + ((size_t)g * 2048 + seq * 128) * 512 + 256 + dir * 128 + p;
            const LAS bf16_t* e = (const LAS bf16_t*)ebuf + sq * 128 * 264 + dir * 128 + p;
            float sr = 0.f, si = 0.f;
            for (int blk = 0; blk < 8; ++blk) {
                float er[16], ei[16];
#pragma unroll
                for (int j = 0; j < 16; ++j) { const int c = dir ? 127 - (blk * 16 + j) : blk * 16 + j; er[j] = __uint_as_float((unsigned)e[c * 264] << 16); ei[j] = __uint_as_float((unsigned)e[c * 264 + 64] << 16); }
#pragma unroll
                for (int j = 0; j < 16; ++j) { const int c = dir ? 127 - (blk * 16 + j) : blk * 16 + j;
                    const unsigned w = cvt_pk_bf16(sr, si);
                    xrow[(size_t)c * 512] = (bf16_t)(w & 0xffffu); xrow[(size_t)c * 512 + 64] = (bf16_t)(w >> 16);
                    const float nr = aL.x * sr - aL.y * si + er[j], ni = aL.x * si + aL.y * sr + ei[j];
                    sr = nr; si = ni; }
            }
        }
        __syncthreads();
    }
};
struct EpiYS : EpiBase {
    unsigned char* ws;
    __device__ __forceinline__ void pair8(const Unit& u, int lrow, int colq, f32x4 a0, f32x4 a1, f32x4 b0, f32x4 b1, const Pre&) {
        const int idx = u.r0 + lrow, b = idx >> 7, c = idx & 127;
#pragma unroll
        for (int bj = 0; bj < 2; ++bj) { const int col = colq + bj * 32, i = col >> 4, h = col & 15; f32x4 lo = bj ? b0 : a0, hi = bj ? b1 : a1;
#pragma unroll
            for (int q = 0; q < 4; ++q) { lo[q] = gelu_tanh(lo[q]); hi[q] = gelu_tanh(hi[q]); }
            bf16_t* p = (bf16_t*)(ws + WS_YS) + (size_t)(b * 2048 + c * 16 + i) * 512 + u.aux * 16 + h; *(u32x4*)p = pack8(lo, hi); }
    }
};
struct EpiFnet : EpiBase {
    bf16_t* O;
    __device__ __forceinline__ void pair8(const Unit& u, int lrow, int colq, f32x4 a0, f32x4 a1, f32x4 b0, f32x4 b1, const Pre&) {
        const u32x4 A = qtr(pack8(a0, a1)), B = qtr(pack8(b0, b1)); const int row = u.r0 + lrow - (int)(threadIdx.x & 15) + QT_ROW; if ((row & 2047) == 1024) return;
        bf16_t* p = O + (size_t)row * 1024 + u.c0 + (colq & ~31) + QT_COL; *(u32x4*)p = A; *(u32x4*)(p + 32) = B;
    }
};
struct EpiP1All : EpiBase {
    unsigned char* ws;
    __device__ __forceinline__ void pair8(const Unit& u, int lrow, int colq, f32x4 a0, f32x4 a1, f32x4 b0, f32x4 b1, const Pre& p) {
        if (u.sub == 0) { EpiP1Main E; E.ws = ws; E.pair8(u, lrow, colq, a0, a1, b0, b1, p); } else { EpiP1Swap E; E.ws = ws; E.pair8(u, lrow, colq, a0, a1, b0, b1, p); }
    }
};
struct EpiP3All : EpiBase {
    unsigned char* ws; bf16_t* Y;
    __device__ __forceinline__ void pair8(const Unit& u, int lrow, int colq, f32x4 a0, f32x4 a1, f32x4 b0, f32x4 b1, const Pre& p) {
        if (u.sub == 0) { EpiYS E; E.ws = ws; E.pair8(u, lrow, colq, a0, a1, b0, b1, p); } else { EpiFnet E; E.O = Y; E.pair8(u, lrow, colq, a0, a1, b0, b1, p); }
    }
};
struct EpiGluM : EpiBase {
    static constexpr bool WHOLE_TILE = true;
    unsigned char* ws; const bf16_t* Y;
    __device__ __forceinline__ void pair8(const Unit&, int, int, f32x4, f32x4, f32x4, f32x4, const Pre&) {}
    __device__ __forceinline__ void tile(f32x4 (&acc)[2][2][4][2], const Unit& u, int wr, int wc, int fr, int fq) {
        const int oc = u.c0 + wc * 32 + fq * 8;
        u32x4 y1[4], y2[4]; u32x2 za[4][2], zb[4][2];
#pragma unroll
        for (int m = 0; m < 4; ++m) { const int k = u.aux * 128 + wr * 64 + m * 16 + fr, tA = u.r0 + k, tB = u.r0 + (k == 0 ? 1024 : 2048 - k);
            y1[m] = *(const u32x4*)(Y + (size_t)tA * 1024 + oc); y2[m] = *(const u32x4*)(Y + (size_t)(tA + 1024) * 1024 + oc);
            za[m][0] = *(const u32x2*)(ws + WS_ZA + (size_t)tA * 1024 + oc); zb[m][0] = *(const u32x2*)(ws + WS_ZB + (size_t)tA * 1024 + oc);
            za[m][1] = *(const u32x2*)(ws + WS_ZA + (size_t)tB * 1024 + oc); zb[m][1] = *(const u32x2*)(ws + WS_ZB + (size_t)tB * 1024 + oc); }
#pragma unroll
        for (int m = 0; m < 4; ++m) { const int k = u.aux * 128 + wr * 64 + m * 16 + fr, tA = u.r0 + k, tB = u.r0 + (k == 0 ? 1024 : 2048 - k);
            const f32x4 p_lo = unpack_lo(y1[m]), p_hi = unpack_hi(y1[m]), q_lo = unpack_lo(y2[m]), q_hi = unpack_hi(y2[m]);
            const f32x4 ybA_lo = k == 0 ? p_lo : p_lo - q_lo, ybA_hi = k == 0 ? p_hi : p_hi - q_hi, ybB_lo = k == 0 ? q_lo : p_lo + q_lo, ybB_hi = k == 0 ? q_hi : p_hi + q_hi;
            const f32x4 a_lo = dq8x4(za[m][0].x) * (acc[0][0][m][0] * sigmoid4(acc[0][1][m][0])) + dq8x4(zb[m][0].x) * ybA_lo;
            const f32x4 a_hi = dq8x4(za[m][0].y) * (acc[0][0][m][1] * sigmoid4(acc[0][1][m][1])) + dq8x4(zb[m][0].y) * ybA_hi;
            const int k2 = k - fr + QT_ROW, tA2 = u.r0 + k2, tB2 = u.r0 + (k2 == 0 ? 1024 : 2048 - k2), oc2 = u.c0 + wc * 32 + QT_COL;
            *(u32x4*)((bf16_t*)(ws + WS_MG) + (size_t)tA2 * 1024 + oc2) = qtr(pack8(a_lo, a_hi));
            const f32x4 b_lo = dq8x4(za[m][1].x) * (acc[1][0][m][0] * sigmoid4(acc[1][1][m][0])) + dq8x4(zb[m][1].x) * ybB_lo;
            const f32x4 b_hi = dq8x4(za[m][1].y) * (acc[1][0][m][1] * sigmoid4(acc[1][1][m][1])) + dq8x4(zb[m][1].y) * ybB_hi;
            *(u32x4*)((bf16_t*)(ws + WS_MG) + (size_t)tB2 * 1024 + oc2) = qtr(pack8(b_lo, b_hi)); }
    }
};
struct ResPre0 { u32x4 a, b; float s; };
struct ResPre1 { u32x4 a, b; };
template <int WHICH> struct EpiRes : EpiBase {
    typedef typename std::conditional<WHICH == 0, ResPre0, ResPre1>::type Pre; static constexpr int MB = 4;
    const float* x; unsigned char* ws; float ss;
    __device__ __forceinline__ void load(const Unit& u, int lrow, int colq, Pre& q) {
        const size_t off = (size_t)(u.r0 + lrow) * 1024 + u.c0 + colq;
        if constexpr (WHICH == 0) { const bf16_t* xn = (const bf16_t*)(ws + WS_XN) + off; q.a = *(const u32x4*)xn; q.b = *(const u32x4*)(xn + 32); q.s = ((const float*)(ws + WS_INVR))[u.r0 + lrow]; }
        else { const bf16_t* xb = (const bf16_t*)(ws + WS_XB) + off; q.a = *(const u32x4*)xb; q.b = *(const u32x4*)(xb + 32); }
    }
    __device__ __forceinline__ void row_begin() { ss = 0.f; }
    __device__ __forceinline__ void pair8(const Unit& u, int lrow, int colq, f32x4 a0, f32x4 a1, f32x4 b0, f32x4 b1, const Pre& q) {
        const size_t off = (size_t)(u.r0 + lrow) * 1024 + u.c0 + colq;
        if constexpr (WHICH == 0) { a0 += unpack_lo(q.a) * q.s; a1 += unpack_hi(q.a) * q.s; b0 += unpack_lo(q.b) * q.s; b1 += unpack_hi(q.b) * q.s; } else { a0 += unpack_lo(q.a); a1 += unpack_hi(q.a); b0 += unpack_lo(q.b); b1 += unpack_hi(q.b); }
        bf16_t* xb = (bf16_t*)(ws + WS_XB) + (size_t)(u.r0 + lrow - (int)(threadIdx.x & 15) + QT_ROW) * 1024 + u.c0 + (colq & ~31) + QT_COL; *(u32x4*)xb = qtr(pack8(a0, a1)); *(u32x4*)(xb + 32) = qtr(pack8(b0, b1));
        const f32x4 s4 = a0 * a0 + a1 * a1 + b0 * b0 + b1 * b1; ss += (s4[0] + s4[1]) + (s4[2] + s4[3]);
    }
    __device__ __forceinline__ void row_end(const Unit& u, int lrow, int slot, int nslots) {
        float s = ss; s += __shfl_xor(s, 16); s += __shfl_xor(s, 32);
        if ((threadIdx.x & 63) < 16) { float* p = (float*)(ws + (WHICH ? WS_SSP2 : WS_SSP1)) + (size_t)(u.r0 + lrow) * 16 + (u.c0 >> 8) * 4;
            if (nslots == 1) *(f32x4*)p = (f32x4){s, 0.f, 0.f, 0.f}; else p[slot] = s; }
    }
};
struct EpiUp : EpiBase {
    unsigned char* ws; const LAS float* rs; bf16_t* hlo;
    __device__ __forceinline__ void pair8(const Unit& u, int lrow, int colq, f32x4 a0, f32x4 a1, f32x4 b0, f32x4 b1, const Pre&) {
        const float r = rs[u.slot * 256 + lrow];
        a0 *= r; a1 *= r; b0 *= r; b1 *= r;
#pragma unroll
        for (int j = 0; j < 4; ++j) { a0[j] = a0[j] > 0.f ? a0[j] * a0[j] : 0.f; a1[j] = a1[j] > 0.f ? a1[j] * a1[j] : 0.f; b0[j] = b0[j] > 0.f ? b0[j] * b0[j] : 0.f; b1[j] = b1[j] > 0.f ? b1[j] * b1[j] : 0.f; }
        bf16_t* p = (u.c0 < 2048 ? hlo + u.c0 : (bf16_t*)(ws + WS_HHI) + (u.c0 - 2048)) + (size_t)(u.r0 + lrow - (int)(threadIdx.x & 15) + QT_ROW) * 2048 + (colq & ~31) + QT_COL; *(u32x4*)p = qtr(pack8(a0, a1)); *(u32x4*)(p + 32) = qtr(pack8(b0, b1));
    }
};
struct EpiFinal : EpiBase {
    static constexpr bool WHOLE_TILE = true;
    unsigned char* ws; float* out; const LAS float* rs; const float* gfin;
    __device__ __forceinline__ void pair8(const Unit&, int, int, f32x4, f32x4, f32x4, f32x4, const Pre&) {}
    __device__ __forceinline__ void tile(f32x4 (&acc)[2][2][4][2], const Unit& u, int wr, int wc, int fr, int fq) {
        float* ss3 = (float*)(ws + WS_CTL + CTL_SS3); unsigned* cnt = (unsigned*)(ws + WS_CTL + CTL_CNT) + (u.r0 >> 8) * 64;
        const int colb = u.c0 + wc * 64 + fq * 8;
        u32x4 pk[2][4][2];
#pragma unroll
        for (int ai = 0; ai < 2; ++ai)
#pragma unroll
            for (int m = 0; m < 4; ++m) {
                const int lrow = ai * 128 + wr * 64 + m * 16 + fr; const size_t off = (size_t)(u.r0 + lrow) * 1024 + colb;
                const bf16_t* xb = (const bf16_t*)(ws + WS_XB) + off; const bf16_t* pp = (const bf16_t*)(ws + WS_PP) + off;
                const u32x4 x0 = *(const u32x4*)xb, x1 = *(const u32x4*)(xb + 32), p0 = *(const u32x4*)pp, p1 = *(const u32x4*)(pp + 32);
                const float r = rs[u.slot * 256 + lrow];
                const f32x4 a0 = unpack_lo(x0) + sigmoid4(acc[ai][0][m][0] * r) * unpack_lo(p0), a1 = unpack_hi(x0) + sigmoid4(acc[ai][0][m][1] * r) * unpack_hi(p0);
                const f32x4 b0 = unpack_lo(x1) + sigmoid4(acc[ai][1][m][0] * r) * unpack_lo(p1), b1 = unpack_hi(x1) + sigmoid4(acc[ai][1][m][1] * r) * unpack_hi(p1);
                pk[ai][m][0] = pack8(a0, a1); pk[ai][m][1] = pack8(b0, b1);
                const f32x4 s4 = a0 * a0 + a1 * a1 + b0 * b0 + b1 * b1; float s = (s4[0] + s4[1]) + (s4[2] + s4[3]);
                s += __shfl_xor(s, 16); s += __shfl_xor(s, 32);
                if (fq == 0) (void)__hip_atomic_fetch_add(ss3 + u.r0 + lrow, s, __ATOMIC_RELAXED, __HIP_MEMORY_SCOPE_AGENT);
                asm volatile("" ::: "memory");
            }
        f32x4 gv[2][2];
#pragma unroll
        for (int bj = 0; bj < 2; ++bj)
#pragma unroll
            for (int n = 0; n < 2; ++n) gv[bj][n] = *(const f32x4*)(gfin + colb + bj * 32 + n * 4);
        asm volatile("s_waitcnt vmcnt(0)" ::: "memory");
        if ((threadIdx.x & 63) == 0) (void)__hip_atomic_fetch_add(cnt, 1u, __ATOMIC_RELAXED, __HIP_MEMORY_SCOPE_AGENT);
        { unsigned sp = 0; while ((unsigned)__builtin_amdgcn_readfirstlane(__hip_atomic_load(cnt, __ATOMIC_RELAXED, __HIP_MEMORY_SCOPE_AGENT)) < 32u) { __builtin_amdgcn_s_sleep(1); if (++sp > (1u << 22)) break; } }
#pragma unroll
        for (int ai = 0; ai < 2; ++ai)
#pragma unroll
            for (int m = 0; m < 4; ++m) { const int row = u.r0 + ai * 128 + wr * 64 + m * 16 + fr;
                const float tot = __hip_atomic_load(ss3 + row, __ATOMIC_RELAXED, __HIP_MEMORY_SCOPE_AGENT), rstd = 1.0f / sqrtf(tot * (1.0f / D) + EPS);
                float* o = out + (size_t)(row - fr + QT_ROW) * 1024 + u.c0 + wc * 64 + QT_COL;
                qst(o, unpack_lo(pk[ai][m][0]) * rstd * gv[0][0]); qst(o + 4, unpack_hi(pk[ai][m][0]) * rstd * gv[0][1]);
                qst(o + 32, unpack_lo(pk[ai][m][1]) * rstd * gv[1][0]); qst(o + 36, unpack_hi(pk[ai][m][1]) * rstd * gv[1][1]); }
    }
};

__device__ __forceinline__ int perm32(int rho) { const int n = rho >> 4, i = rho & 15; return 8 * (i >> 2) + 4 * n + (i & 3); }
template <class Epi, class SegT>
__device__ __forceinline__ void gemm_simple(const SegT& S, Epi& E) {
    const int tid = threadIdx.x, wave = __builtin_amdgcn_readfirstlane(tid >> 6), lane = tid & 63, fr = lane & 15, fq = lane >> 4;
    constexpr int lda = SegT::lda(), ldb = SegT::ldb(), K = SegT::K();
    static_assert(!SegT::CUSTOMA && !SegT::SPLITA && !Epi::WHOLE_TILE, "the simple body has no mirrored-row staging and no whole-tile epilogue: run this segment on the fast body");
    Unit u;
    for (int i = 0; S.next(i, u); ++i) {
        for (int ai = 0; ai < 2; ++ai) {
            const int lrow = ai * 128 + wave * 16 + fr;
            const bf16_t* ap = u.A + (size_t)lrow * lda + fq * 8;
            E.row_begin();
            for (int wc = 0; wc < 4; ++wc) {
                f32x4 acc[2][2];
#pragma unroll
                for (int bj = 0; bj < 2; ++bj)
#pragma unroll
                    for (int n = 0; n < 2; ++n) {
                        int brow = wc * 64 + bj * 32 + perm32(n * 16 + fr);
                        if constexpr (SegT::CUSTOMB) { const int pos = u.c0 + wc * 32 + perm32(n * 16 + fr); brow = bj ? (pos == 0 ? 1024 : 2048 - pos) : pos; }
                        const bf16_t* bp = u.B + (size_t)brow * ldb + fq * 8;
                        f32x4 a = {0.f, 0.f, 0.f, 0.f};
#pragma unroll 4
                        for (int k = 0; k < K; k += 32) a = __builtin_amdgcn_mfma_f32_16x16x32_bf16(*(const bf16x8*)(bp + k), *(const bf16x8*)(ap + k), a, 0, 0, 0);
                        acc[bj][n] = a;
                    }
                typename Epi::Pre pre; E.load(u, lrow, wc * 64 + fq * 8, pre);
                E.pair8(u, lrow, wc * 64 + fq * 8, acc[0][0], acc[0][1], acc[1][0], acc[1][1], pre);
            }
            E.row_end(u, lrow, 0, 1);
            E.half_done(u, ai);
        }
    }
}

constexpr int BM = 256, BK = 64, HALF = 128, HTB = HALF * BK * 2;
__device__ __forceinline__ int lds_byte(int r, int c) { const int st = (r >> 4) * 2 + (c >> 5), rr = r & 15, cc = c & 31, ob = rr * 64 + cc * 2; return st * 1024 + (ob ^ (((ob >> 9) & 1) << 5)); }
__device__ __forceinline__ void stage_rc(int b, int& R, int& C) { const int st = b / 1024, sb = b % 1024, swz = sb ^ (((sb >> 9) & 1) << 5); R = (st >> 1) * 16 + swz / 64; C = (st & 1) * 32 + (swz % 64) / 2; }

#ifndef PG8_ALIGN
#define PG8_ALIGN true
#endif
#ifndef PG8_SP2
#define PG8_SP2 true
#endif
struct NoHook { __device__ __forceinline__ void operator()() const {} };
template <class Epi, class SegT, class Hook = NoHook, bool ALIGN_EPI = PG8_ALIGN, bool SP2 = PG8_SP2>
__device__ __forceinline__ void gemm_fast(LAS unsigned char* lds, const SegT& S, Epi& E, const Hook& hook = Hook()) {
    const int tid = threadIdx.x, wid = __builtin_amdgcn_readfirstlane(tid >> 6), lane = tid & 63, wr = wid >> 2, wc = wid & 3, fr = lane & 15, fq = lane >> 4;
    constexpr int lda = SegT::lda(), ldb = SegT::ldb(), K = SegT::K(), nt = K / BK;
    unsigned voffA[2], voffB0[2], voffB1[2];
#pragma unroll
    for (int i = 0; i < 2; ++i) { int R, C; stage_rc(tid * 16 + i * 8192, R, C); voffA[i] = (unsigned)(R * lda + C) * 2u;
        const int Rb = (R >> 5) * 64 + perm32(R & 31); voffB0[i] = (unsigned)(Rb * ldb + C) * 2u; voffB1[i] = (unsigned)((Rb + 32) * ldb + C) * 2u; }
    constexpr size_t kstep = (size_t)(BK * 2);
    constexpr size_t hstepA = (size_t)HALF * lda * 2;
    int voffAh[2], voffAhS[2];
#pragma unroll
    for (int i = 0; i < 2; ++i) { int R, C; stage_rc(tid * 16 + i * 8192, R, C); voffAh[i] = ((127 - R) * lda + C) * 2; voffAhS[i] = voffAh[i] - (R == 0 ? 1024 * lda * 2 : 0); }
#define PG8_STAGE_AH(bufoff, base_lo, base_hi, special) do { if constexpr (SegT::CUSTOMA) { _Pragma("unroll") for (int _i = 0; _i < 2; ++_i) \
        __builtin_amdgcn_global_load_lds((const unsigned*)((const char*)(base_hi) + (long)((special) ? voffAhS[_i] : voffAh[_i])), (LAS unsigned*)(lds + (bufoff) + ldsw + _i * 8192), 16, 0, 0); } \
        else { PG8_STAGE(bufoff, (const char*)(base_lo) + hstepA, voffA); } } while (0)
    const unsigned ldsw = (unsigned)wid * 1024u;
    const int aoff = lds_byte(wr * 64 + fr, fq * 8), boff = lds_byte(wc * 32 + fr, fq * 8);
#define PG8_SA(b, h) (((b) * 2 + (h)) * HTB)
#define PG8_SB(b, h) ((4 + (b) * 2 + (h)) * HTB)
#define PG8_STAGE(bufoff, gbase, voff) do { _Pragma("unroll") for (int _i = 0; _i < 2; ++_i) \
        __builtin_amdgcn_global_load_lds((const unsigned*)((const char*)(gbase) + (voff)[_i]), (LAS unsigned*)(lds + (bufoff) + ldsw + _i * 8192), 16, 0, 0); } while (0)
#define PG8_LDA(dst, b, h) do { _Pragma("unroll") for (int m = 0; m < 4; ++m) _Pragma("unroll") for (int k = 0; k < 2; ++k) dst[m][k] = *(const LAS bf16x8*)(lds + PG8_SA(b, h) + aoff + m * 2048 + k * 1024); } while (0)
#define PG8_LDB(dst, b, h) do { _Pragma("unroll") for (int n = 0; n < 2; ++n) _Pragma("unroll") for (int k = 0; k < 2; ++k) dst[n][k] = *(const LAS bf16x8*)(lds + PG8_SB(b, h) + boff + n * 2048 + k * 1024); } while (0)
#define PG8_MMA(ai, bj, At, Bt) do { __builtin_amdgcn_s_setprio(1); _Pragma("unroll") for (int m = 0; m < 4; ++m) _Pragma("unroll") for (int n = 0; n < 2; ++n) _Pragma("unroll") for (int k = 0; k < 2; ++k) \
        acc[ai][bj][m][n] = __builtin_amdgcn_mfma_f32_16x16x32_bf16(Bt[n][k], At[m][k], acc[ai][bj][m][n], 0, 0, 0); __builtin_amdgcn_s_setprio(0); } while (0)
#define PG8_WAIT_V(n) asm volatile("s_waitcnt vmcnt(" #n ")" ::: "memory")
#define PG8_WAIT_L(n) asm volatile("s_waitcnt lgkmcnt(" #n ")" ::: "memory")
#define PG8_BAR __builtin_amdgcn_s_barrier()
#define PG8_SCHED __builtin_amdgcn_sched_barrier(0)
#define PG8_EPILOGUE() do { if constexpr (Epi::WHOLE_TILE) { static_assert(!Epi::WHOLE_TILE || ALIGN_EPI, "the exchange in a whole-tile epilogue needs both half-workgroups in the epilogue together"); E.tile(acc, cur, wr, wc, fr, fq); } else { _Pragma("unroll") for (int ai = 0; ai < 2; ++ai) { _Pragma("unroll") for (int mb = 0; mb < 4; mb += Epi::MB) { typename Epi::Pre pre[Epi::MB]; \
        _Pragma("unroll") for (int mm = 0; mm < Epi::MB; ++mm) E.load(cur, ai * HALF + wr * 64 + (mb + mm) * 16 + fr, wc * 64 + fq * 8, pre[mm]); \
        _Pragma("unroll") for (int mm = 0; mm < Epi::MB; ++mm) { const int lrow = ai * HALF + wr * 64 + (mb + mm) * 16 + fr; E.row_begin(); \
            E.pair8(cur, lrow, wc * 64 + fq * 8, acc[ai][0][mb + mm][0], acc[ai][0][mb + mm][1], acc[ai][1][mb + mm][0], acc[ai][1][mb + mm][1], pre[mm]); E.row_end(cur, lrow, wc, 4); } } E.half_done(cur, ai); } } } while (0)
    Unit cur, nxt; int ui = 0;
    if (!S.next(0, cur)) return;
    if constexpr (SegT::CUSTOMB) {
#pragma unroll
        for (int i = 0; i < 2; ++i) { int R, C; stage_rc(tid * 16 + i * 8192, R, C); const int pos = cur.c0 + (R >> 5) * 32 + perm32(R & 31), mir = pos == 0 ? 1024 : 2048 - pos;
            voffB0[i] = (unsigned)(pos * ldb + C) * 2u; voffB1[i] = (unsigned)(mir * ldb + C) * 2u; }
    }
    f32x4 acc[2][2][4][2];
#pragma unroll
    for (int a = 0; a < 2; ++a)
#pragma unroll
        for (int b = 0; b < 2; ++b)
#pragma unroll
            for (int m = 0; m < 4; ++m)
#pragma unroll
                for (int n = 0; n < 2; ++n) acc[a][b][m][n] = (f32x4){0.f, 0.f, 0.f, 0.f};
    bf16x8 At[4][2], B0[2][2], B1[2][2];
    const char* cA = (const char*)cur.A; const char* cB = (const char*)cur.B; const char* cA2 = SegT::CUSTOMA ? (const char*)cur.A2 : cA;
    const char* cAhi = SegT::SPLITA ? (const char*)cur.A2 - (size_t)(nt / 2) * (size_t)(BK * 2) : cA;
    if constexpr (SP2) {
        PG8_STAGE(PG8_SB(0, 0), cB, voffB0); PG8_STAGE(PG8_SB(0, 1), cB, voffB1); PG8_STAGE(PG8_SA(0, 0), cA, voffA); PG8_STAGE_AH(PG8_SA(0, 1), cA, cA2, cur.sub != 0);
        hook();
        if (wr == 1) PG8_BAR;
        PG8_WAIT_V(2); PG8_BAR;
        PG8_STAGE(PG8_SB(1, 0), cB + kstep, voffB0); PG8_STAGE(PG8_SA(1, 0), cA + kstep, voffA); PG8_STAGE(PG8_SB(1, 1), cB + kstep, voffB1);
        PG8_WAIT_V(6); PG8_BAR;
    } else {
        PG8_STAGE(PG8_SB(0, 0), cB, voffB0); PG8_STAGE(PG8_SA(0, 0), cA, voffA); PG8_STAGE(PG8_SB(0, 1), cB, voffB1); PG8_STAGE_AH(PG8_SA(0, 1), cA, cA2, cur.sub != 0);
        if (wr == 1) PG8_BAR;
        PG8_WAIT_V(4); PG8_BAR;
        PG8_STAGE(PG8_SB(1, 0), cB + kstep, voffB0); PG8_STAGE(PG8_SA(1, 0), cA + kstep, voffA); PG8_STAGE(PG8_SB(1, 1), cB + kstep, voffB1);
        PG8_WAIT_V(6); PG8_BAR;
    }
    for (;;) {
        const bool has_next = S.next(ui + 1, nxt);
        const char* nA = has_next ? (const char*)nxt.A : cA; const char* nB = has_next ? (const char*)nxt.B : cB;
        const char* nA2 = SegT::CUSTOMA ? (has_next ? (const char*)nxt.A2 : cA2) : nA; const bool nsub = has_next ? (nxt.sub != 0) : (cur.sub != 0);
        const char* nAhi = SegT::SPLITA ? (has_next ? (const char*)nxt.A2 - (size_t)(nt / 2) * (size_t)(BK * 2) : cAhi) : nA;
        _Pragma("nounroll") for (int t = 0; t < nt; t += 2) {
            const bool last = (t == nt - 2);
            const char* sd0 = (SegT::SPLITA && t >= nt / 2) ? cAhi : cA; const char* sd2 = (SegT::SPLITA && t + 2 >= nt / 2) ? cAhi : cA;
            const char* a1 = sd0 + (size_t)(t + 1) * kstep;
            const char* a2 = last ? nA : sd2 + (size_t)(t + 2) * kstep; const char* b2 = last ? nB : cB + (size_t)(t + 2) * kstep;
            const char* a3 = a2 + kstep; const char* b3 = b2 + kstep;
            const char* a1h = cA2 + (size_t)(t + 1) * kstep; const char* a2h = last ? nA2 : cA2 + (size_t)(t + 2) * kstep; const bool s1 = cur.sub != 0, s2 = last ? nsub : (cur.sub != 0);
            if constexpr (SP2) {
            PG8_LDB(B0, 0, 0); PG8_LDB(B1, 0, 1); PG8_SCHED; PG8_LDA(At, 0, 0); PG8_STAGE_AH(PG8_SA(1, 1), a1, a1h, s1);
            PG8_WAIT_V(8); PG8_WAIT_L(0); PG8_BAR; PG8_MMA(0, 0, At, B0); PG8_MMA(0, 1, At, B1); PG8_BAR; PG8_SCHED;
            PG8_LDA(At, 0, 1); PG8_STAGE(PG8_SB(0, 0), b2, voffB0); PG8_STAGE(PG8_SB(0, 1), b2, voffB1); PG8_STAGE(PG8_SA(0, 0), a2, voffA);
            PG8_WAIT_V(8); PG8_WAIT_L(0); PG8_BAR; PG8_MMA(1, 0, At, B0); PG8_MMA(1, 1, At, B1); PG8_BAR; PG8_SCHED;
            PG8_LDB(B0, 1, 0); PG8_LDB(B1, 1, 1); PG8_SCHED; PG8_LDA(At, 1, 0); PG8_STAGE_AH(PG8_SA(0, 1), a2, a2h, s2);
            PG8_WAIT_V(8); PG8_WAIT_L(0); PG8_BAR; PG8_MMA(0, 0, At, B0); PG8_MMA(0, 1, At, B1); PG8_BAR; PG8_SCHED;
            PG8_LDA(At, 1, 1); PG8_STAGE(PG8_SB(1, 0), b3, voffB0); PG8_STAGE(PG8_SB(1, 1), b3, voffB1); PG8_STAGE(PG8_SA(1, 0), a3, voffA);
            PG8_WAIT_V(8); PG8_WAIT_L(0); PG8_BAR; PG8_MMA(1, 0, At, B0); PG8_MMA(1, 1, At, B1); PG8_BAR; PG8_SCHED;
            } else {
            PG8_LDB(B0, 0, 0); PG8_SCHED; PG8_LDA(At, 0, 0); PG8_STAGE_AH(PG8_SA(1, 1), a1, a1h, s1);
            PG8_WAIT_L(8); PG8_BAR; PG8_WAIT_L(0); PG8_MMA(0, 0, At, B0); PG8_BAR; PG8_SCHED;
            PG8_LDB(B1, 0, 1); PG8_STAGE(PG8_SB(0, 0), b2, voffB0);
            PG8_BAR; PG8_WAIT_L(0); PG8_MMA(0, 1, At, B1); PG8_BAR;
            PG8_LDA(At, 0, 1); PG8_STAGE(PG8_SA(0, 0), a2, voffA);
            PG8_BAR; PG8_WAIT_L(0); PG8_MMA(1, 0, At, B0); PG8_BAR; PG8_SCHED;
            PG8_STAGE(PG8_SB(0, 1), b2, voffB1);
            PG8_WAIT_V(6); PG8_BAR; PG8_MMA(1, 1, At, B1); PG8_BAR;
            PG8_LDB(B0, 1, 0); PG8_SCHED; PG8_LDA(At, 1, 0); PG8_STAGE_AH(PG8_SA(0, 1), a2, a2h, s2);
            PG8_WAIT_L(8); PG8_BAR; PG8_WAIT_L(0); PG8_MMA(0, 0, At, B0); PG8_BAR; PG8_SCHED;
            PG8_LDB(B1, 1, 1); PG8_STAGE(PG8_SB(1, 0), b3, voffB0);
            PG8_BAR; PG8_WAIT_L(0); PG8_MMA(0, 1, At, B1); PG8_BAR;
            PG8_LDA(At, 1, 1); PG8_STAGE(PG8_SA(1, 0), a3, voffA);
            PG8_BAR; PG8_WAIT_L(0); PG8_MMA(1, 0, At, B0); PG8_BAR; PG8_SCHED;
            PG8_STAGE(PG8_SB(1, 1), b3, voffB1);
            PG8_WAIT_V(6); PG8_BAR; PG8_MMA(1, 1, At, B1); PG8_BAR;
            }
        }
        if constexpr (ALIGN_EPI) { if (wr == 0) PG8_BAR; }
        if constexpr (!Epi::AFTER_DRAIN) { PG8_EPILOGUE(); }
        if (!has_next) break;
#pragma unroll
        for (int a = 0; a < 2; ++a)
#pragma unroll
            for (int b = 0; b < 2; ++b)
#pragma unroll
                for (int m = 0; m < 4; ++m)
#pragma unroll
                    for (int n = 0; n < 2; ++n) acc[a][b][m][n] = (f32x4){0.f, 0.f, 0.f, 0.f};
        cur = nxt; cA = nA; cB = nB; cA2 = nA2; cAhi = nAhi; ++ui;
        if constexpr (ALIGN_EPI) { if (wr == 1) PG8_BAR; }
    }
    PG8_WAIT_V(0);
    if constexpr (!ALIGN_EPI) { if (wr == 0) PG8_BAR; }
    PG8_BAR;
    if constexpr (Epi::AFTER_DRAIN) { PG8_EPILOGUE(); }
#undef PG8_SA
#undef PG8_SB
#undef PG8_STAGE
#undef PG8_STAGE_AH
#undef PG8_LDA
#undef PG8_LDB
#undef PG8_MMA
#undef PG8_WAIT_V
#undef PG8_WAIT_L
#undef PG8_BAR
#undef PG8_SCHED
#undef PG8_EPILOGUE
}

template <int KIND, class Epi, class Hook = NoHook>
__device__ __forceinline__ void run_segment(LAS unsigned char* lds, unsigned char* ws, int G, Epi& E, const Hook& hook = Hook(), const void* ext = nullptr) {
    Seg<KIND> S; S.ws = ws; S.G = G; S.c = blockIdx.x; S.only = -1; S.ext = ext;
    if constexpr ((FAST_MASK >> KIND) & 1) {
        if constexpr (Epi::AFTER_DRAIN || Seg<KIND>::CUSTOMB) { hook(); const int n = S.count(); for (int i = 0; i < n; ++i) { S.only = i; gemm_fast<Epi, Seg<KIND>>(lds, S, E); } }
        else gemm_fast<Epi, Seg<KIND>, Hook>(lds, S, E, hook);
        __syncthreads();
    } else {
        hook(); gemm_simple<Epi, Seg<KIND>>(S, E);
    }
}

__device__ __forceinline__ void transpose_item(const float* W, int K, int N, bf16_t* WT, const float* gk, int glu_map, LAS float* scr, int item, int lane) {
    const int nblk = N / 64, kb = item / nblk, nb = item % nblk, k0 = 32 * kb, n0 = 64 * nb;
    f32x4 tv[8];
#pragma unroll
    for (int i = 0; i < 8; ++i) { const int kk = 4 * i + (lane >> 4); tv[i] = __builtin_nontemporal_load((const f32x4*)(W + (size_t)(k0 + kk) * N + n0 + 4 * (lane & 15))); }
#pragma unroll
    for (int i = 0; i < 8; ++i) { const int kk = 4 * i + (lane >> 4); f32x4 v = tv[i]; if (gk) v = v * gk[k0 + kk]; *(LAS f32x4*)(scr + kk * 68 + 4 * (lane & 15)) = v; }
    LDS_WAIT(); asm volatile("" ::: "memory");
    const int c = lane & 3;
#pragma unroll
    for (int j = 0; j < 4; ++j) { const int n = (lane >> 2) + 16 * j; const LAS float* s = scr + (8 * c) * 68 + n;
        int d = n0 + n;
        if (glu_map) { const int v = d < 1024 ? d : d - 1024; d = (v >> 7) * 256 + ((v >> 5) & 3) * 64 + (d < 1024 ? 0 : 32) + (v & 31); }
        u32x4 o; o.x = cvt_pk_bf16(s[0 * 68], s[1 * 68]); o.y = cvt_pk_bf16(s[2 * 68], s[3 * 68]); o.z = cvt_pk_bf16(s[4 * 68], s[5 * 68]); o.w = cvt_pk_bf16(s[6 * 68], s[7 * 68]);
        *(u32x4*)(WT + (size_t)d * K + k0 + 8 * c) = o; }
    LDS_WAIT(); asm volatile("" ::: "memory");
}

struct In { const float *x, *p, *g_mix, *w_in, *lam_re, *lam_im, *log_dt, *b_re, *b_im, *c_re, *c_im, *d_skip, *w_glu, *w_fnet, *w_out, *g_ffn, *w_up, *w_down, *g_ple, *w_ple_gate, *w_ple, *g_final; };

template <int NI>
__device__ __forceinline__ void s5_tables(const In& in, unsigned char* ws, LAS unsigned char* lds, int gp0, int gp1) {
    constexpr int ISZ = 17408 + 16384 + 16384 + 4096;
    const int tid = threadIdx.x;
    float s1_lr = 0.f, s1_li = 0.f, s1_ldt = 0.f;
    const int it1 = (tid >> 7) & (NI - 1), gp_1 = it1 ? gp1 : gp0;
    if (tid < 128 * NI) { const int t = tid & 127, d = t >> 6, p = t & 63, gi = d * 32 + (gp_1 >> 3); s1_lr = in.lam_re[gi * 64 + p]; s1_li = in.lam_im[gi * 64 + p]; s1_ldt = in.log_dt[gi]; }
    float p_lr[4 * NI], p_li[4 * NI], p_br[4 * NI], p_bi[4 * NI], p_cr[4 * NI], p_ci[4 * NI];
#pragma unroll
    for (int k = 0; k < 4 * NI; ++k) { const int g = ((k >> 2) ? gp1 : gp0) >> 3, el = tid + (k & 3) * NTHR;
        const int d = el >> 10, p = (el >> 4) & 63, h = el & 15, gi = d * 32 + g, h2 = (el >> 6) & 15, p2 = el & 63;
        p_lr[k] = in.lam_re[gi * 64 + p]; p_li[k] = in.lam_im[gi * 64 + p];
        p_br[k] = in.b_re[((size_t)gi * 64 + p) * 16 + h]; p_bi[k] = in.b_im[((size_t)gi * 64 + p) * 16 + h];
        p_cr[k] = in.c_re[((size_t)gi * 16 + h2) * 64 + p2]; p_ci[k] = in.c_im[((size_t)gi * 16 + h2) * 64 + p2]; }
    const float dsk00 = in.d_skip[(gp0 >> 3) * 16 + 2 * (gp0 & 7)], dsk01 = in.d_skip[(gp0 >> 3) * 16 + 2 * (gp0 & 7) + 1], dsk10 = in.d_skip[(gp1 >> 3) * 16 + 2 * (gp1 & 7)], dsk11 = in.d_skip[(gp1 >> 3) * 16 + 2 * (gp1 & 7) + 1];
    if (tid < 128 * NI) {
        LAS f32x2* apow = (LAS f32x2*)(lds + it1 * ISZ);
        const int t = tid & 127, d = t >> 6, p = t & 63, g = gp_1 >> 3;
        const float dt = expf(s1_ldt), mag = expf(s1_lr * dt), ar = mag * cosf(s1_li * dt), ai = mag * sinf(s1_li * dt);
        float zr = 1.f, zi = 0.f;
        for (int m = 0; m <= 16; ++m) { apow[(d * 17 + m) * 64 + p] = (f32x2){zr, zi}; const float nr = zr * ar - zi * ai; zi = zr * ai + zi * ar; zr = nr; }
        if ((gp_1 & 7) == 0) ((f32x2*)(ws + WS_AL))[(g * 2 + d) * 64 + p] = apow[(d * 17 + 16) * 64 + p];
    }
    __syncthreads();
#pragma unroll
    for (int k = 0; k < 4 * NI; ++k) { const int it = k >> 2, el = tid + (k & 3) * NTHR;
        LAS f32x2* apow = (LAS f32x2*)(lds + it * ISZ); LAS f32x2* bbar = (LAS f32x2*)(lds + it * ISZ + 17408); LAS f32x2* cc = (LAS f32x2*)(lds + it * ISZ + 17408 + 16384);
        const int d = el >> 10, p = (el >> 4) & 63, h = el & 15, h2 = (el >> 6) & 15, p2 = el & 63;
        const float lr = p_lr[k], li = p_li[k];
        const f32x2 a = apow[(d * 17 + 1) * 64 + p]; const float nr = a.x - 1.f, ni = a.y, den = 1.f / (lr * lr + li * li);
        const float qr = (nr * lr + ni * li) * den, qi = (ni * lr - nr * li) * den;
        bbar[(d * 64 + p) * 16 + h] = (f32x2){qr * p_br[k] - qi * p_bi[k], qr * p_bi[k] + qi * p_br[k]};
        cc[(d * 16 + h2) * 64 + p2] = (f32x2){p_cr[k], p_ci[k]};
    }
    __syncthreads();
#pragma unroll
    for (int it = 0; it < NI; ++it) {
        LAS f32x2* apow = (LAS f32x2*)(lds + it * ISZ); LAS f32x2* bbar = (LAS f32x2*)(lds + it * ISZ + 17408); LAS f32x2* cc = (LAS f32x2*)(lds + it * ISZ + 17408 + 16384); LAS float* Kt = (LAS float*)(lds + it * ISZ + 17408 + 32768);
        const int part = (it ? gp1 : gp0) & 7;
        const int pq = tid & 7, combo = tid >> 3, d = combo >> 5, hpl = (combo >> 4) & 1, h = combo & 15, hp = 2 * part + hpl; float kk[16];
#pragma unroll
        for (int m = 0; m < 16; ++m) kk[m] = 0.f;
#pragma unroll
        for (int pi = 0; pi < 8; ++pi) { const int p = pq * 8 + pi; const f32x2 c = cc[(d * 16 + hp) * 64 + p], b = bbar[(d * 64 + p) * 16 + h], a = apow[(d * 17 + 1) * 64 + p];
            float zr = c.x * b.x - c.y * b.y, zi = c.x * b.y + c.y * b.x;
#pragma unroll
            for (int m = 0; m < 16; ++m) { kk[m] += zr; const float nr = zr * a.x - zi * a.y; zi = zr * a.y + zi * a.x; zr = nr; } }
#pragma unroll
        for (int m = 0; m < 16; ++m) { float v = kk[m]; v += __shfl_xor(v, 1); v += __shfl_xor(v, 2); v += __shfl_xor(v, 4); if (pq == 0) Kt[((d * 16 + m) * 2 + hpl) * 16 + h] = v; }
    }
    __syncthreads();
#pragma unroll
    for (int k = 0; k < 4 * NI; ++k) { const int it = k >> 2, e = tid + (k & 3) * NTHR, gp = it ? gp1 : gp0, g = gp >> 3, part = gp & 7;
        LAS f32x2* apow = (LAS f32x2*)(lds + it * ISZ); LAS f32x2* cc = (LAS f32x2*)(lds + it * ISZ + 17408 + 16384); LAS float* Kt = (LAS float*)(lds + it * ISZ + 17408 + 32768);
        bf16_t* W5 = (bf16_t*)(ws + WS_WS5) + (size_t)g * 131072;
        const int rl = e >> 6, i = rl >> 1, hpl = rl & 1, hp = 2 * part + hpl, r = i * 16 + hp, c8 = (e & 63) * 8; float v[8];
        if (c8 < 256) { const int j = c8 >> 4, h0 = c8 & 15;
#pragma unroll
            for (int q = 0; q < 8; ++q) { const int h = h0 + q; float x;
                if (j < i) x = Kt[((0 * 16 + (i - j)) * 2 + hpl) * 16 + h]; else if (j > i) x = Kt[((1 * 16 + (j - i)) * 2 + hpl) * 16 + h];
                else { x = Kt[((0 * 16 + 0) * 2 + hpl) * 16 + h] + Kt[((1 * 16 + 0) * 2 + hpl) * 16 + h]; if (h == hp) x += it ? (hpl ? dsk11 : dsk10) : (hpl ? dsk01 : dsk00); }
                v[q] = x; }
        } else { const int s = c8 - 256, d = s >> 7, pt = (s >> 6) & 1, p0 = s & 63, m = d ? 16 - i : i + 1;
#pragma unroll
            for (int q = 0; q < 8; ++q) { const f32x2 c = cc[(d * 16 + hp) * 64 + p0 + q], a = apow[(d * 17 + m) * 64 + p0 + q];
                v[q] = pt ? -(c.x * a.y + c.y * a.x) : (c.x * a.x - c.y * a.y); }
        }
        u32x4 o; o.x = cvt_pk_bf16(v[0], v[1]); o.y = cvt_pk_bf16(v[2], v[3]); o.z = cvt_pk_bf16(v[4], v[5]); o.w = cvt_pk_bf16(v[6], v[7]);
        *(u32x4*)(W5 + (size_t)r * 512 + c8) = o;
    }
#pragma unroll
    for (int k = 0; k < 2 * NI; ++k) { const int it = k >> 1, e = tid + (k & 1) * NTHR, gp = it ? gp1 : gp0, g = gp >> 3, part = gp & 7;
        LAS f32x2* apow = (LAS f32x2*)(lds + it * ISZ); LAS f32x2* bbar = (LAS f32x2*)(lds + it * ISZ + 17408);
        bf16_t* MBt = (bf16_t*)(ws + WS_MB) + (size_t)g * 65536;
        const int s = part * 32 + (e >> 5), c8 = (e & 31) * 8, d = s >> 7, pt = (s >> 6) & 1, p = s & 63, j = c8 >> 4, h0 = c8 & 15, m = d ? j : 15 - j; float v[8];
        const f32x2 a = apow[(d * 17 + m) * 64 + p];
#pragma unroll
        for (int q = 0; q < 8; ++q) { const f32x2 b = bbar[(d * 64 + p) * 16 + h0 + q]; v[q] = pt ? (a.x * b.y + a.y * b.x) : (a.x * b.x - a.y * b.y); }
        u32x4 o; o.x = cvt_pk_bf16(v[0], v[1]); o.y = cvt_pk_bf16(v[2], v[3]); o.z = cvt_pk_bf16(v[4], v[5]); o.w = cvt_pk_bf16(v[6], v[7]);
        *(u32x4*)(MBt + (size_t)s * 256 + c8) = o;
    }
    __syncthreads();
}

constexpr int CW_XNQ = 40960;
__device__ __forceinline__ void xn_pass(const In& in, unsigned char* ws, LAS unsigned char* lds, int lane, int wave) {
    unsigned* ctr = (unsigned*)(ws + WS_CTL) + CW_XNQ;
    volatile LAS int* sl = (volatile LAS int*)(lds + MISC_OFF + 256);
    const int tid = threadIdx.x;
    if (tid == 0) sl[0] = (int)xb_add(ctr, 1u);
    __syncthreads();
    for (int it = 0;; ++it) {
        const int c = sl[it & 1]; if (c >= T / 32) break;
        if (tid == 0) sl[(it + 1) & 1] = (int)xb_add(ctr, 1u);
        const int m0 = c * 32 + wave * 4;
        f32x4 v[4][4]; float s[4];
#pragma unroll
        for (int r = 0; r < 4; ++r) { const f32x4* xr = (const f32x4*)(in.x + (size_t)(m0 + r) * D) + lane;
#pragma unroll
            for (int j = 0; j < 4; ++j) v[r][j] = __builtin_nontemporal_load(xr + 64 * j); }
#pragma unroll
        for (int r = 0; r < 4; ++r) { s[r] = 0.f;
#pragma unroll
            for (int j = 0; j < 4; ++j) s[r] += (v[r][j][0] * v[r][j][0] + v[r][j][1] * v[r][j][1]) + (v[r][j][2] * v[r][j][2] + v[r][j][3] * v[r][j][3]); }
#pragma unroll
        for (int r = 0; r < 4; ++r) { const float rms = sqrtf(wave_sum(s[r]) * (1.0f / D) + EPS), rstd = 1.0f / rms;
            if (lane == 0) ((float*)(ws + WS_INVR))[m0 + r] = rms;
            u32x2* o = (u32x2*)((bf16_t*)(ws + WS_XN) + (size_t)(m0 + r) * D) + lane;
#pragma unroll
            for (int j = 0; j < 4; ++j) o[64 * j] = pack4(v[r][j] * rstd); }
        __syncthreads();
    }
    __syncthreads();
}

__device__ __forceinline__ void p0_prologue(const In& in, unsigned char* ws, LAS unsigned char* lds, int G) {
    const int tid = threadIdx.x, lane = tid & 63, wave = __builtin_amdgcn_readfirstlane(tid >> 6);
    const int bx = blockIdx.x;
    const bool split = (G % 16) == 0;
    const bool roleA = split ? ((bx >> 3) & 1) != 0 : true, roleB = split ? !roleA : true;
    const int nR = split ? G / 2 : G, ir = split ? ((bx >> 4) * 8 + (bx & 7)) : bx;
    if (roleA) {
        for (int gp = ir; gp < NG * 8; gp += 2 * nR) { if (gp + nR < NG * 8) s5_tables<2>(in, ws, lds, gp, gp + nR); else s5_tables<1>(in, ws, lds, gp, gp); }
        const int gt = ir * NTHR + tid, NGT = nR * NTHR;
        LAS f32x2* trig = (LAS f32x2*)lds;
        if (tid < 128) { const float ang = (float)tid * (1.0f / 64.0f); trig[tid] = (f32x2){cospif(ang), sinpif(ang)}; }
        __syncthreads();
        for (int e2 = gt; e2 < 2 * 256 * 4 * 32; e2 += NGT) {
            const int jh = e2 & 1, e = e2 >> 1, c4 = e & 255, g4 = (e >> 8) & 3, c0 = (e >> 10) * 4;
            f32x4 ac[4], as[4];
#pragma unroll
            for (int q = 0; q < 4; ++q) { ac[q] = (f32x4){0.f, 0.f, 0.f, 0.f}; as[q] = (f32x4){0.f, 0.f, 0.f, 0.f}; }
            const float* wsrc = in.w_fnet + (size_t)(g4 * 128 + jh * 64) * 1024 + 4 * c4;
#define WC_LOAD(W, J0) { _Pragma("unroll") for (int jj = 0; jj < 16; ++jj) W[jj] = *(const f32x4*)(wsrc + (size_t)((J0) + jj) * 1024); }
#define WC_COMP(W, J0) { _Pragma("unroll") for (int jj = 0; jj < 16; ++jj) { _Pragma("unroll") for (int q = 0; q < 4; ++q) { const f32x2 cs = trig[((jh * 64 + (J0) + jj) * (c0 + q)) & 127]; ac[q] += cs.x * W[jj]; as[q] += cs.y * W[jj]; } } }
            f32x4 wa[16], wb[16];
            WC_LOAD(wa, 0); WC_LOAD(wb, 16); WC_COMP(wa, 0); WC_LOAD(wa, 32); WC_COMP(wb, 16); WC_LOAD(wb, 48); WC_COMP(wa, 32); WC_COMP(wb, 48);
#undef WC_LOAD
#undef WC_COMP
#pragma unroll
            for (int q = 0; q < 4; ++q) {
#pragma unroll
                for (int k = 0; k < 4; ++k) { ac[q][k] += __shfl_xor(ac[q][k], 1); as[q][k] += __shfl_xor(as[q][k], 1); } }
            const float s = 1.0f / 512.0f;
            bf16_t* dst = (bf16_t*)(ws + (jh ? WS_WSN : WS_WC));
#pragma unroll
            for (int k = 0; k < 4; ++k) { u32x2 o;
                if (jh) { o.x = cvt_pk_bf16(as[0][k] * s, as[1][k] * s); o.y = cvt_pk_bf16(as[2][k] * s, as[3][k] * s); }
                else { o.x = cvt_pk_bf16(ac[0][k] * s, ac[1][k] * s); o.y = cvt_pk_bf16(ac[2][k] * s, ac[3][k] * s); }
                *(u32x2*)(dst + (size_t)(4 * c4 + k) * 512 + g4 * 128 + c0) = o; }
        }
        __syncthreads();
        LAS float* ctab = (LAS float*)(lds + 4096);
        for (int i = tid; i < 2048; i += NTHR) ctab[i] = cospif((float)i * (1.0f / 1024.0f));
        __syncthreads();
        for (int e = gt; e < 2 * 1024 * 128; e += NGT) {
            const int which = e >> 17, k = (e >> 7) & 1023, n0 = (e & 127) * 8, sh = which ? 1536 : 0; float v[8];
#pragma unroll
            for (int q = 0; q < 8; ++q) v[q] = ctab[(k * (n0 + q) + sh) & 2047];
            u32x4 o; o.x = cvt_pk_bf16(v[0], v[1]); o.y = cvt_pk_bf16(v[2], v[3]); o.z = cvt_pk_bf16(v[4], v[5]); o.w = cvt_pk_bf16(v[6], v[7]);
            *(u32x4*)((bf16_t*)(ws + WS_DM) + (size_t)which * 1024 * 1024 + (size_t)k * 1024 + n0) = o;
        }
        __syncthreads();
    }
    if (roleB) {
        const int gw = ir * NWAVES + wave, NGW = nR * NWAVES;
        const int gt = ir * NTHR + tid, NGT = nR * NTHR;
        {
            LAS float* scr = (LAS float*)(lds + wave * 8704);
            constexpr int I_IN = (1024 / 32) * (3072 / 64), I_PLE = (256 / 32) * (1024 / 64), I_GLU = (512 / 32) * (2048 / 64), I_OUT = (1024 / 32) * (1024 / 64), I_UP = (1024 / 32) * (4096 / 64), I_DOWN = (4096 / 32) * (1024 / 64), I_G = I_OUT;
            constexpr int NITEMS = I_IN + I_PLE + I_GLU + I_OUT + I_UP + I_DOWN + I_G;
            for (int it = gw; it < NITEMS; it += NGW) {
                int r = it;
                if (r < I_IN) { transpose_item(in.w_in, 1024, 3072, (bf16_t*)(ws + WS_WIN), in.g_mix, 0, scr, r, lane); continue; } r -= I_IN;
                if (r < I_PLE) { transpose_item(in.w_ple, 256, 1024, (bf16_t*)(ws + WS_WPLE), nullptr, 0, scr, r, lane); continue; } r -= I_PLE;
                if (r < I_GLU) { transpose_item(in.w_glu, 512, 2048, (bf16_t*)(ws + WS_WGLU), nullptr, 1, scr, r, lane); continue; } r -= I_GLU;
                if (r < I_OUT) { transpose_item(in.w_out, 1024, 1024, (bf16_t*)(ws + WS_WOUT), nullptr, 0, scr, r, lane); continue; } r -= I_OUT;
                if (r < I_UP) { transpose_item(in.w_up, 1024, 4096, (bf16_t*)(ws + WS_WUP), in.g_ffn, 0, scr, r, lane); continue; } r -= I_UP;
                if (r < I_DOWN) { transpose_item(in.w_down, 4096, 1024, (bf16_t*)(ws + WS_WDOWN), nullptr, 0, scr, r, lane); continue; } r -= I_DOWN;
                transpose_item(in.w_ple_gate, 1024, 1024, (bf16_t*)(ws + WS_WG), in.g_ple, 0, scr, r, lane);
            }
        }
        for (int c0 = gw * 4; c0 < T * DPLE / 1024; c0 += NGW * 4) {
            f32x4 v[4][4];
#pragma unroll
            for (int r = 0; r < 4; ++r) { const f32x4* pr = (const f32x4*)in.p + (size_t)(c0 + r) * 256 + lane;
#pragma unroll
                for (int j = 0; j < 4; ++j) v[r][j] = __builtin_nontemporal_load(pr + 64 * j); }
#pragma unroll
            for (int r = 0; r < 4; ++r) { u32x2* o = (u32x2*)(ws + WS_PB) + (size_t)(c0 + r) * 256 + lane;
#pragma unroll
                for (int j = 0; j < 4; ++j) o[64 * j] = pack4(v[r][j]); }
        }
    }
    __syncthreads();
    xn_pass(in, ws, lds, lane, wave);
}

template <int KIND>
__device__ __forceinline__ void rstd_table(LAS unsigned char* lds, unsigned char* ws, int G, size_t ssp_off) {
    LAS float* rs = (LAS float*)(lds + RS_OFF); LAS int* r0s = (LAS int*)(lds + RS_OFF + 8192);
    Seg<KIND> S; S.ws = ws; S.G = G; S.c = blockIdx.x; S.only = -1;
    const int tid = threadIdx.x;
    if (tid < 8) { Unit u; r0s[tid] = S.next(tid, u) ? u.r0 : -1; }
    __syncthreads();
    for (int e = tid; e < 8 * 256; e += NTHR) { const int r0 = r0s[e >> 8]; if (r0 < 0) continue;
        const f32x4* p = (const f32x4*)((const float*)(ws + ssp_off) + (size_t)(r0 + (e & 255)) * 16);
        const f32x4 a = p[0], b = p[1], c = p[2], d = p[3];
        const float s = ((a[0] + a[1]) + (a[2] + a[3])) + ((b[0] + b[1]) + (b[2] + b[3])) + ((c[0] + c[1]) + (c[2] + c[3])) + ((d[0] + d[1]) + (d[2] + d[3]));
        rs[e] = 1.0f / sqrtf(s * (1.0f / D) + EPS); }
    __syncthreads();
}

struct Args { const float* in[22]; float* out; unsigned char* ws; int ph_lo, ph_hi, coop, pad; };
constexpr int N_PHASES = 9;

__global__ void __launch_bounds__(NTHR, 2) fwd_kernel(Args args) {
    extern __shared__ __attribute__((aligned(16))) unsigned char lds_raw[];
    LAS unsigned char* lds = (LAS unsigned char*)lds_raw;
    unsigned char* ws = args.ws;
    const int G = gridDim.x, tid = threadIdx.x, lane = tid & 63, wave = __builtin_amdgcn_readfirstlane(tid >> 6);
    In in; { const float* const* q = args.in; in.x = q[0]; in.p = q[1]; in.g_mix = q[2]; in.w_in = q[3]; in.lam_re = q[4]; in.lam_im = q[5]; in.log_dt = q[6]; in.b_re = q[7]; in.b_im = q[8]; in.c_re = q[9]; in.c_im = q[10];
        in.d_skip = q[11]; in.w_glu = q[12]; in.w_fnet = q[13]; in.w_out = q[14]; in.g_ffn = q[15]; in.w_up = q[16]; in.w_down = q[17]; in.g_ple = q[18]; in.w_ple_gate = q[19]; in.w_ple = q[20]; in.g_final = q[21]; }
    const int lo = args.ph_lo, hi = args.ph_hi;
#define IN_PH(k) (lo <= (k) && (k) < hi)
    if (args.coop == 2) cg::this_grid().sync();
    { volatile LAS unsigned* misc = (volatile LAS unsigned*)(lds + MISC_OFF); if (tid < 16) misc[tid] = 0u; }
    __syncthreads();
    XcdBarrier bar; bar.bar = (unsigned*)(ws + WS_CTL) + CW_BAR; bar.x = 0; bar.st = (volatile LAS unsigned*)(lds + MISC_OFF);
    if (args.coop) bar = xcd_barrier_post((unsigned*)(ws + WS_CTL) + CW_BAR, (volatile LAS unsigned*)(lds + MISC_OFF));
    const bool use_team = (G == 256) && args.coop;
    TeamBar tbar; { const int x_ = blockIdx.x & 7, k_ = blockIdx.x >> 3; tbar.cnt = (unsigned*)(ws + WS_CTL) + CW_TEAMC + (x_ * 8 + (k_ & 7)) * 64; tbar.target = 0u; tbar.same = false;
        if (use_team && tid == 0) ((unsigned*)(ws + WS_CTL))[CW_TEAMX + (x_ * 8 + (k_ & 7)) * 4 + (k_ >> 3)] = 0x100u | xb_xcc_id(); }
#define SEAM(k) do { if (IN_PH(k) && IN_PH((k) + 1)) { if (use_team && ((k) == 5 || (k) == 6 || (k) == 7)) team_barrier(tbar); else xcd_barrier(bar);     \
        if ((k) == 3 && use_team) { const unsigned* tx_ = (const unsigned*)(ws + WS_CTL) + CW_TEAMX + ((blockIdx.x & 7) * 8 + ((blockIdx.x >> 3) & 7)) * 4; \
            const unsigned a_ = xb_ld((unsigned*)tx_), b_ = xb_ld((unsigned*)tx_ + 1), c_ = xb_ld((unsigned*)tx_ + 2), d_ = xb_ld((unsigned*)tx_ + 3); tbar.same = (a_ >= 0x100u) && a_ == b_ && a_ == c_ && a_ == d_; } } } while (0)

#define PHASE_BODY_0 { p0_prologue(in, ws, lds, G); __syncthreads(); }
    if (IN_PH(0)) { PHASE_BODY_0 if ((PROBE_DUP >> 0) & 1) { PHASE_BODY_0 } }
    SEAM(0);
#define PHASE_BODY_1 { \
        { EpiP1Main E; E.ws = ws; run_segment<SG_P1MAIN>(lds, ws, G, E); } \
        { EpiP1Swap E; E.ws = ws; run_segment<SG_P1SWAP>(lds, ws, G, E); } \
        { EpiStore E; E.O = (bf16_t*)(ws + WS_PP); E.ldo = 1024; run_segment<SG_P1PP>(lds, ws, G, E); } \
    }
    if (IN_PH(1)) { PHASE_BODY_1 if ((PROBE_DUP >> 1) & 1) { PHASE_BODY_1 } }
    SEAM(1);
#define PHASE_BODY_2 { \
        { EpiScan E; E.ws = ws; E.ebuf = (LAS float*)lds; run_segment<SG_E>(lds, ws, G, E); } \
        { EpiDft E; E.ws = ws; run_segment<SG_DFT>(lds, ws, G, E); } \
        for (int o = (blockIdx.x * NWAVES + wave); o < NB * 512; o += G * NWAVES) {        \
            const bf16_t* er = (const bf16_t*)(ws + WS_UT) + (size_t)o * 1024 + lane * 16; \
            const u32x4 w0 = *(const u32x4*)er, w1 = *(const u32x4*)(er + 8); \
            const f32x4 x0 = unpack_lo(w0), x1 = unpack_hi(w0), x2 = unpack_lo(w1), x3 = unpack_hi(w1); \
            float s = ((x0[0] - x0[1]) + (x0[2] - x0[3])) + ((x1[0] - x1[1]) + (x1[2] - x1[3])) + ((x2[0] - x2[1]) + (x2[2] - x2[3])) + ((x3[0] - x3[1]) + (x3[2] - x3[3])); \
            s = wave_sum(s) + ((const float*)(ws + WS_U1024))[o]; \
            if (lane == 0) ((bf16_t*)(ws + WS_R))[((size_t)(o >> 9) * 2048 + 1024) * 512 + (o & 511)] = (bf16_t)(cvt_pk_bf16(s, 0.f) & 0xffffu); \
        } \
    }
    if (IN_PH(2)) { PHASE_BODY_2 if ((PROBE_DUP >> 2) & 1) { PHASE_BODY_2 } }
    SEAM(2);
#define PHASE_BODY_3 { \
        { EpiP3All E; E.ws = ws; E.Y = (bf16_t*)args.out; run_segment<SG_P3ALL>(lds, ws, G, E); } \
        \
        for (int it_ = blockIdx.x * NWAVES + wave; it_ < 1024 * (NB / 4); it_ += G * NWAVES) {        \
            const int col = it_ >> 2, bg = it_ & 3; \
            const u32x4 wv = *(const u32x4*)((const bf16_t*)(ws + WS_WC) + (size_t)col * 512 + lane * 8); \
            const f32x4 w0 = unpack_lo(wv), w1 = unpack_hi(wv); float sn[4]; \
_Pragma("unroll") \
            for (int j = 0; j < 4; ++j) { const u32x4 rv = *(const u32x4*)((const bf16_t*)(ws + WS_R) + ((size_t)(bg * 4 + j) * 2048 + 1024) * 512 + lane * 8); const f32x4 a0 = unpack_lo(rv), a1 = unpack_hi(rv); \
                sn[j] = ((a0[0] * w0[0] + a0[1] * w0[1]) + (a0[2] * w0[2] + a0[3] * w0[3])) + ((a1[0] * w1[0] + a1[1] * w1[1]) + (a1[2] * w1[2] + a1[3] * w1[3])); } \
_Pragma("unroll") \
            for (int j = 0; j < 4; ++j) sn[j] = wave_sum(sn[j]); \
            if (lane < 4) { const float v = lane == 0 ? sn[0] : lane == 1 ? sn[1] : lane == 2 ? sn[2] : sn[3]; \
                ((bf16_t*)args.out)[((size_t)(bg * 4 + lane) * 2048 + 1024) * 1024 + col] = (bf16_t)(cvt_pk_bf16(v, 0.f) & 0xffffu); } \
        } \
    }
    if (IN_PH(3)) { PHASE_BODY_3 if ((PROBE_DUP >> 3) & 1) { PHASE_BODY_3 } }
    SEAM(3);
#define PHASE_BODY_4 { EpiGluM E; E.ws = ws; E.Y = (const bf16_t*)args.out; run_segment<SG_GLU>(lds, ws, G, E); }
    if (IN_PH(4)) { PHASE_BODY_4 if ((PROBE_DUP >> 4) & 1) { PHASE_BODY_4 } }
    SEAM(4);
#define PHASE_BODY_5 { EpiRes<0> E; E.x = in.x; E.ws = ws; E.ss = 0.f; run_segment<SG_OUT>(lds, ws, G, E); }
    if (IN_PH(5)) { PHASE_BODY_5 if ((PROBE_DUP >> 5) & 1) { PHASE_BODY_5 } }
    SEAM(5);
#define PHASE_BODY_6 { EpiUp E; E.ws = ws; E.rs = (const LAS float*)(lds + RS_OFF); E.hlo = (bf16_t*)args.out; run_segment<SG_UP>(lds, ws, G, E, [&]() { rstd_table<SG_UP>(lds, ws, G, WS_SSP1); }); }
    if (IN_PH(6)) { PHASE_BODY_6 if ((PROBE_DUP >> 6) & 1) { PHASE_BODY_6 } }
    SEAM(6);
    if (IN_PH(7)) { EpiRes<1> E; E.x = nullptr; E.ws = ws; E.ss = 0.f; run_segment<SG_DOWN>(lds, ws, G, E, NoHook(), (const void*)args.out); }
    SEAM(7);
    if (IN_PH(8)) { EpiFinal E; E.ws = ws; E.out = args.out; E.rs = (const LAS float*)(lds + RS_OFF); E.gfin = in.g_final; run_segment<SG_GATE>(lds, ws, G, E, [&]() { rstd_table<SG_GATE>(lds, ws, G, WS_SSP2); }); }
#undef IN_PH
#undef SEAM
}


#if DBG_STOP >= 0
__device__ __forceinline__ float bf2f(bf16_t v) { return __uint_as_float(((unsigned)v) << 16); }
__global__ void dbg_dump(float* dst, const float* out, const unsigned char* ws, int k) {
    const size_t n = (size_t)T * D;
    for (size_t i = (size_t)blockIdx.x * blockDim.x + threadIdx.x; i < n; i += (size_t)gridDim.x * blockDim.x) {
        float v = 0.f;
        if (k == 0) { v = bf2f(((const bf16_t*)(ws + WS_XN))[i]) + 2.f * bf2f(((const bf16_t*)(ws + WS_WIN))[i % (3072 * 1024)]) + 3.f * bf2f(((const bf16_t*)(ws + WS_WS5))[i % (32 * 256 * 512)]) + 5.f * bf2f(((const bf16_t*)(ws + WS_MB))[i % (32 * 65536)])
                    + 7.f * bf2f(((const bf16_t*)(ws + WS_DM))[i % (2048 * 2048)]) + 11.f * bf2f(((const bf16_t*)(ws + WS_WC))[i % (1024 * 512)]) + 13.f * bf2f(((const bf16_t*)(ws + WS_WSN))[i % (1024 * 512)]) + 0.5f * bf2f(((const bf16_t*)(ws + WS_PB))[i % ((size_t)T * 256)])
                    + bf2f(((const bf16_t*)(ws + WS_WGLU))[i % (2048 * 512)]) + bf2f(((const bf16_t*)(ws + WS_WUP))[i % (4096 * 1024)]) + bf2f(((const bf16_t*)(ws + WS_WDOWN))[i % (4096 * 1024)]) + bf2f(((const bf16_t*)(ws + WS_WG))[i % (1024 * 1024)]) + bf2f(((const bf16_t*)(ws + WS_WOUT))[i % (1024 * 1024)]) + bf2f(((const bf16_t*)(ws + WS_WPLE))[i % (1024 * 256)]) + ((const float*)(ws + WS_AL))[i % 8192]; }
        if (k == 1) { v = bf2f(((const bf16_t*)(ws + WS_ZA))[i]) + 2.f * bf2f(((const bf16_t*)(ws + WS_ZB))[i]) + 3.f * bf2f(((const bf16_t*)(ws + WS_PP))[i]) + 5.f * bf2f(((const bf16_t*)(ws + WS_XS))[(i & ~511ull) + (i & 255)]) + 7.f * bf2f(((const bf16_t*)(ws + WS_UT))[i % ((size_t)T * 512)]); }
        if (k == 2) { v = bf2f(((const bf16_t*)(ws + WS_XS))[i]) + 3.f * bf2f(((const bf16_t*)(ws + WS_R))[i % ((size_t)T * 512)]); }
        if (k == 3) { v = bf2f(((const bf16_t*)out)[i]) + 3.f * bf2f(((const bf16_t*)(ws + WS_YS))[i % ((size_t)T * 512)]); }
        if (k == 4) { v = bf2f(((const bf16_t*)(ws + WS_MG))[i]); }
        dst[i] = v;
    }
}
#endif
extern "C" void kernel_launch(void* const* d_in, const int* in_sizes, int n_in, void* d_out, int out_size, void* d_ws, size_t ws_size, hipStream_t stream) {
    static int grid = 0;
    if (grid == 0) {
        if (n_in != 22 || in_sizes[0] != T * D || out_size != T * D || ws_size < WS_END) { fprintf(stderr, "kernel_launch: unexpected problem (n_in %d, in0 %d, out %d, ws %zu < %zu)\n", n_in, n_in > 0 ? in_sizes[0] : -1, out_size, ws_size, (size_t)WS_END); grid = -1; return; }
        int dev = 0, cus = 0, per_cu = 0;
        if (hipGetDevice(&dev) != hipSuccess || hipDeviceGetAttribute(&cus, hipDeviceAttributeMultiprocessorCount, dev) != hipSuccess) { grid = -1; return; }
        if (hipFuncSetAttribute((const void*)fwd_kernel, hipFuncAttributeMaxDynamicSharedMemorySize, LDS_BYTES) != hipSuccess) { fprintf(stderr, "kernel_launch: hipFuncSetAttribute failed\n"); grid = -1; return; }
        if (hipOccupancyMaxActiveBlocksPerMultiprocessor(&per_cu, (const void*)fwd_kernel, NTHR, LDS_BYTES) != hipSuccess || per_cu < 1) { fprintf(stderr, "kernel_launch: occupancy query says %d blocks per CU\n", per_cu); (void)hipGetLastError(); per_cu = 1; }
        grid = cus * (per_cu < 1 ? 1 : 1);
    }
    if (grid < 0) return;
    (void)hipMemsetAsync((char*)d_ws + WS_CTL, 0, CTL_BYTES, stream);
    Args a{};
    for (int i = 0; i < 22; ++i) a.in[i] = (const float*)d_in[i];
    a.out = (float*)d_out; a.ws = (unsigned char*)d_ws;
#if N_LAUNCH_MODE
#if DBG_STOP >= 0
    for (int ph = 0; ph <= DBG_STOP; ++ph) { a.ph_lo = ph; a.ph_hi = ph + 1; a.coop = 0; hipLaunchKernelGGL(fwd_kernel, dim3(grid), dim3(NTHR), LDS_BYTES, stream, a); }
    if (DBG_STOP == 3) { hipLaunchKernelGGL(dbg_dump, dim3(2048), dim3(256), 0, stream, (float*)((char*)d_ws + WS_PP), (const float*)d_out, (const unsigned char*)d_ws, (int)DBG_STOP);
        (void)hipMemcpyAsync(d_out, (char*)d_ws + WS_PP, (size_t)T * D * 4, hipMemcpyDeviceToDevice, stream); }
    else if (DBG_STOP <= 4) hipLaunchKernelGGL(dbg_dump, dim3(2048), dim3(256), 0, stream, (float*)d_out, (const float*)d_out, (const unsigned char*)d_ws, (int)DBG_STOP);
#else
    for (int ph = 0; ph < N_PHASES; ++ph) { a.ph_lo = ph; a.ph_hi = ph + 1; a.coop = 0; hipLaunchKernelGGL(fwd_kernel, dim3(grid), dim3(NTHR), LDS_BYTES, stream, a); }
#endif
#else
    a.ph_lo = 0; a.ph_hi = N_PHASES; a.coop = 1;
    void* kargs[] = {&a};
    hipError_t e = hipLaunchCooperativeKernel((const void*)fwd_kernel, dim3(grid), dim3(NTHR), kargs, LDS_BYTES, stream);
    if (e != hipSuccess) fprintf(stderr, "kernel_launch: cooperative launch failed: %s (grid %d)\n", hipGetErrorString(e), grid);
#endif
}
```
